# Optimizing an MI355X kernel written in HIP

```python
import math
import jax, jax.numpy as jnp
from jax import lax
import numpy as np

D_MODEL = 2048
BATCH = 2
SEQ = 8192
DEPTH = 2

GRID_W = 64
CTX_LEN = 256
N_BRANCH = 4
BRANCH_W = 512
BLOCK = 128
ROPE_BASE = 10000.0
EPS = 1e-6
D_FF = 4 * D_MODEL
DA_HEADS = 4
DA_DIM = 64
SSM_HEADS = 8
SSM_HEAD_DIM = 64
SSM_INNER = SSM_HEADS * SSM_HEAD_DIM
SSM_GROUPS = 2
SSM_STATE = 128
SSM_XBC = SSM_INNER + 2 * SSM_GROUPS * SSM_STATE
SSM_CONV = 5
SSM_CHUNK = 128
SW_HEADS = 8
SW_KV_HEADS = 2
SW_DIM = 64
SW_WINDOW = 128
NA_HEADS = 8
NA_DIM = 64
NA_ROWS = 8
NA_COLS = 16
IN_SPLITS = (DA_HEADS * 2 * DA_DIM, DA_HEADS * 2 * DA_DIM, DA_HEADS * 2 * DA_DIM,
             SSM_INNER, SSM_XBC, 2 * SSM_HEADS,
             SW_HEADS * SW_DIM, SW_KV_HEADS * SW_DIM, SW_KV_HEADS * SW_DIM,
             NA_HEADS * NA_DIM, NA_HEADS * NA_DIM, NA_HEADS * NA_DIM,
             N_BRANCH * D_MODEL)
IN_COLS = sum(IN_SPLITS)

kernel_name = "hybrid_diff_ssd_swa_na_dit_block"


def rmsnorm(t, g):
    tf = t.astype(jnp.float32)
    y = tf * lax.rsqrt(jnp.mean(tf * tf, -1, keepdims=True) + EPS)
    return (y * g.astype(jnp.float32)).astype(t.dtype)


def modulate(t, shift, scale):
    return t * (1 + scale) + shift


def split_cols(p):
    idx, acc = [], 0
    for w in IN_SPLITS[:-1]:
        acc += w
        idx.append(acc)
    return jnp.split(p, idx, axis=-1)


def axial_rope(n, d):
    t = jnp.arange(n)
    row = (t // GRID_W).astype(jnp.float32)
    col = (t % GRID_W).astype(jnp.float32)
    nf = d // 4
    inv = ROPE_BASE ** (-jnp.arange(nf, dtype=jnp.float32) / nf)
    ang = jnp.concatenate([row[:, None] * inv, col[:, None] * inv], -1)
    return jnp.cos(ang), jnp.sin(ang)


def apply_rope(t, cos, sin):
    shape = (t.shape[1],) + (1,) * (t.ndim - 3) + (cos.shape[-1],)
    cos = cos.reshape(shape)
    sin = sin.reshape(shape)
    t1, t2 = jnp.split(t.astype(jnp.float32), 2, -1)
    return jnp.concatenate([t1 * cos - t2 * sin, t2 * cos + t1 * sin], -1).astype(t.dtype)


def ctx_attend(q, k, v, sink=None):
    B, L, H, d = q.shape
    KV = k.shape[2]
    G = H // KV
    s = jnp.einsum('bqhgd,bkhd->bhgqk', q.reshape(B, L, KV, G, d), k).astype(jnp.float32) * d ** -0.5
    if sink is not None:
        s_sink = jnp.broadcast_to(sink.astype(jnp.float32).reshape(1, KV, G, 1, 1), s.shape[:-1] + (1,))
        s = jnp.concatenate([s, s_sink], -1)
    p = jax.nn.softmax(s, -1)[..., :k.shape[1]]
    o = jnp.einsum('bhgqk,bkhd->bqhgd', p.astype(v.dtype), v)
    return o.reshape(B, L, H * d)


def diff_core(q, k, v, lam):
    s = jnp.einsum('bqhmd,bkhmd->bhmqk', q, k).astype(jnp.float32) * q.shape[-1] ** -0.5
    p = jax.nn.softmax(s, -1)
    a = p[:, :, 0] - lam * p[:, :, 1]
    return jnp.einsum('bhqk,bkhe->bqhe', a.astype(v.dtype), v)


def diff_attn_latent(q, k_all, v_all, lam):
    B, N = q.shape[:2]
    nb = N // BLOCK
    qb = jnp.moveaxis(q.reshape((B, nb, BLOCK) + q.shape[2:]), 1, 0)
    o = lax.map(lambda qq: diff_core(qq, k_all, v_all, lam), qb)
    return jnp.moveaxis(o, 0, 1).reshape((B, N) + o.shape[3:])


def window_attn_latent(q, k, v, k_ctx, v_ctx, sink):
    B, N, H, d = q.shape
    KV = k.shape[2]
    G = H // KV
    nb = N // BLOCK
    qb = q.reshape(B, nb, BLOCK, KV, G, d)
    pad = ((0, 0), (BLOCK, BLOCK), (0, 0), (0, 0))
    kp = jnp.pad(k, pad).reshape(B, nb + 2, BLOCK, KV, d)
    vp = jnp.pad(v, pad).reshape(B, nb + 2, BLOCK, KV, d)
    k_band = jnp.concatenate([kp[:, :-2], kp[:, 1:-1], kp[:, 2:]], axis=2)
    v_band = jnp.concatenate([vp[:, :-2], vp[:, 1:-1], vp[:, 2:]], axis=2)
    scale = d ** -0.5
    s_win = jnp.einsum('bnqhgd,bnjhd->bnhgqj', qb, k_band).astype(jnp.float32) * scale
    blk = jnp.arange(nb)[:, None]
    q_pos = blk * BLOCK + jnp.arange(BLOCK)[None, :]
    k_pos = (blk - 1) * BLOCK + jnp.arange(3 * BLOCK)[None, :]
    kq = k_pos[:, None, :]
    valid = (jnp.abs(kq - q_pos[:, :, None]) <= SW_WINDOW) & (kq >= 0) & (kq < N)
    s_win = jnp.where(valid[None, :, None, None], s_win, -jnp.inf)
    s_ctx = jnp.einsum('bnqhgd,bjhd->bnhgqj', qb, k_ctx).astype(jnp.float32) * scale
    s_sink = jnp.broadcast_to(sink.astype(jnp.float32).reshape(1, 1, KV, G, 1, 1), s_ctx.shape[:-1] + (1,))
    p = jax.nn.softmax(jnp.concatenate([s_win, s_ctx, s_sink], -1), -1)
    nw = 3 * BLOCK
    L = k_ctx.shape[1]
    o = (jnp.einsum('bnhgqj,bnjhd->bnqhgd', p[..., :nw].astype(v.dtype), v_band)
         + jnp.einsum('bnhgqj,bjhd->bnqhgd', p[..., nw:nw + L].astype(v.dtype), v_ctx))
    return o.reshape(B, N, H * d)


def neighbourhood_attn_latent(q, k, v, k_ctx, v_ctx, rpb):
    B, N, H, d = q.shape
    W = GRID_W
    R = N // W
    KR = min(NA_ROWS, R)
    KC = NA_COLS
    qg = q.reshape(B, R, W, H, d)
    kg = k.reshape(B, R, W, H, d)
    vg = v.reshape(B, R, W, H, d)
    r = jnp.arange(R)
    row_idx = jnp.clip(r - KR // 2, 0, R - KR)[:, None] + jnp.arange(KR)[None, :]
    cc = jnp.arange(W)
    col_idx = jnp.clip(cc - KC // 2, 0, W - KC)[:, None] + jnp.arange(KC)[None, :]
    k_rows = kg[:, row_idx]
    v_rows = vg[:, row_idx]
    scale = d ** -0.5
    s_rows = jnp.einsum('brqhd,brjkhd->brhqjk', qg, k_rows)
    idx = jnp.broadcast_to(col_idx[:, None, :], (B, R, H, W, KR, KC))
    s_nb = jnp.take_along_axis(s_rows, idx, axis=-1).astype(jnp.float32) * scale
    ro = row_idx - r[:, None] + NA_ROWS - 1
    co = col_idx - cc[:, None] + NA_COLS - 1
    bias = rpb[:, ro[:, None, :, None], co[None, :, None, :]]
    s_nb = s_nb + jnp.moveaxis(bias, 0, 1)[None].astype(jnp.float32)
    s_ctx = jnp.einsum('brqhd,bjhd->brhqj', qg, k_ctx).astype(jnp.float32) * scale
    nk = KR * KC
    p = jax.nn.softmax(jnp.concatenate([s_nb.reshape(B, R, H, W, nk), s_ctx], -1), -1)
    p_nb = p[..., :nk].reshape(B, R, H, W, KR, KC).astype(v.dtype)
    onehot = (col_idx[:, :, None] == cc[None, None, :]).astype(v.dtype)
    p_rows = jnp.einsum('brhqjm,qmk->brhqjk', p_nb, onehot)
    o = (jnp.einsum('brhqjk,brjkhd->brqhd', p_rows, v_rows)
         + jnp.einsum('brhqj,bjhd->brqhd', p[..., nk:].astype(v.dtype), v_ctx))
    return o.reshape(B, N, H * d)


def dwconv(t, w, b):
    K = w.shape[0]
    y = lax.conv_general_dilated(t, w[:, None, :].astype(t.dtype), window_strides=(1,),
                                 padding=[(K // 2, K // 2)], dimension_numbers=('NWC', 'WIO', 'NWC'),
                                 feature_group_count=t.shape[-1])
    return y + b.astype(t.dtype)


def ssd_scan(x, dt, a, bm, cm, h0, with_y=True):
    Bn, n, H, P = x.shape
    G, S = bm.shape[2], bm.shape[3]
    R = H // G
    Lc = SSM_CHUNK
    nc = n // Lc
    xg = (x.astype(jnp.float32) * dt[..., None]).reshape(Bn, nc, Lc, G, R, P)
    bc = bm.astype(jnp.float32).reshape(Bn, nc, Lc, G, S)
    cc = cm.astype(jnp.float32).reshape(Bn, nc, Lc, G, S)
    acum = jnp.cumsum((dt * a).reshape(Bn, nc, Lc, G, R), axis=2)
    decay_states = jnp.exp(acum[:, :, -1:] - acum)
    states = jnp.einsum('bclgn,bclgr,bclgrp->bcgrpn', bc, decay_states, xg)
    chunk_decay = jnp.exp(acum[:, :, -1])

    def step(h, inp):
        dec, st = inp
        return h * dec[..., None, None] + st, h

    h_final, h_prev = lax.scan(step, h0, (jnp.moveaxis(chunk_decay, 1, 0), jnp.moveaxis(states, 1, 0)))
    if not with_y:
        return None, h_final
    seg = acum[:, :, :, None] - acum[:, :, None, :]
    tril = (jnp.arange(Lc)[:, None] >= jnp.arange(Lc)[None, :])[None, None, :, :, None, None]
    ldec = jnp.exp(jnp.where(tril, seg, -jnp.inf))
    cb = jnp.einsum('bclgn,bcsgn->bclsg', cc, bc)
    y_diag = jnp.einsum('bclsgr,bcsgrp->bclgrp', cb[..., None] * ldec, xg)
    y_off = jnp.einsum('bclgn,cbgrpn,bclgr->bclgrp', cc, h_prev, jnp.exp(acum))
    y = (y_diag + y_off).reshape(Bn, n, H, P).astype(x.dtype)
    return y, h_final


def ssm_branch(z, xbc, dtr, zc, xbcc, dtrc, conv_w, conv_b, dt_bias, a_log, d_skip, g_ssm, need_ctx):
    A = -jnp.exp(a_log.astype(jnp.float32))

    def prep(xbc_, dtr_):
        Bn, n = xbc_.shape[:2]
        u = jax.nn.silu(dwconv(xbc_, conv_w, conv_b))
        xs, bm, cm = jnp.split(u, [SSM_INNER, SSM_INNER + SSM_GROUPS * SSM_STATE], -1)
        xs = xs.reshape(Bn, n, SSM_HEADS, SSM_HEAD_DIM)
        bm = bm.reshape(Bn, n, SSM_GROUPS, SSM_STATE)
        cm = cm.reshape(Bn, n, SSM_GROUPS, SSM_STATE)
        dt = jax.nn.softplus(dtr_.reshape(Bn, n, 2, SSM_HEADS).astype(jnp.float32) + dt_bias.astype(jnp.float32))
        return xs, bm, cm, dt

    xs, bm, cm, dt = prep(xbc, dtr)
    xsc, bmc, cmc, dtc = prep(xbcc, dtrc)
    h0 = jnp.zeros((xs.shape[0], SSM_GROUPS, SSM_HEADS // SSM_GROUPS, SSM_HEAD_DIM, SSM_STATE), jnp.float32)
    fl = lambda t: jnp.flip(t, 1)
    yc_f, hc_f = ssd_scan(xsc, dtc[:, :, 0], A[0], bmc, cmc, h0, need_ctx)
    y_f, _ = ssd_scan(xs, dt[:, :, 0], A[0], bm, cm, hc_f)
    yc_b, hc_b = ssd_scan(fl(xsc), fl(dtc[:, :, 1]), A[1], fl(bmc), fl(cmc), h0, need_ctx)
    y_b, _ = ssd_scan(fl(xs), fl(dt[:, :, 1]), A[1], fl(bm), fl(cm), hc_b)

    def finish(yf, yb_rev, xs_, z_):
        y = yf + fl(yb_rev) + d_skip[:, None].astype(xs_.dtype) * xs_
        return rmsnorm(y.reshape(z_.shape) * jax.nn.silu(z_), g_ssm)

    y = finish(y_f, y_b, xs, z)
    if not need_ctx:
        return y, None
    return y, finish(yc_f, yc_b, xsc, zc)


def merge(ys, gate, w_branch, w_out):
    D = w_out.shape[0]
    g = jax.nn.sigmoid(gate).reshape(gate.shape[:-1] + (N_BRANCH, D))
    m = g[..., 0, :] * (ys[0] @ w_branch[0])
    for i in range(1, N_BRANCH):
        m = m + g[..., i, :] * (ys[i] @ w_branch[i])
    return m @ w_out


def mixer(h, hc, cos, sin, lam_init, need_ctx, w_in, lam_q1, lam_k1, lam_q2, lam_k2, g_subln,
          conv_w, conv_b, dt_bias, a_log, d_skip, g_ssm, sink, rpb, w_branch, w_out):
    B, N, _ = h.shape
    L = hc.shape[1]
    aq, ak, av, bz, bx, bdt, sq, sk, sv, nq, nk, nv, gate = split_cols(h @ w_in)
    aqc, akc, avc, bzc, bxc, bdtc, sqc, skc, svc, nqc, nkc, nvc, gatec = split_cols(hc @ w_in)
    lam = (jnp.exp(jnp.sum(lam_q1.astype(jnp.float32) * lam_k1.astype(jnp.float32)))
           - jnp.exp(jnp.sum(lam_q2.astype(jnp.float32) * lam_k2.astype(jnp.float32))) + lam_init)
    qa = apply_rope(aq.reshape(B, N, DA_HEADS, 2, DA_DIM), cos, sin)
    ka = apply_rope(ak.reshape(B, N, DA_HEADS, 2, DA_DIM), cos, sin)
    va = av.reshape(B, N, DA_HEADS, 2 * DA_DIM)
    kac = akc.reshape(B, L, DA_HEADS, 2, DA_DIM)
    vac = avc.reshape(B, L, DA_HEADS, 2 * DA_DIM)
    oa = diff_attn_latent(qa, jnp.concatenate([ka, kac], 1), jnp.concatenate([va, vac], 1), lam)
    ya = (rmsnorm(oa, g_subln) * (1.0 - lam_init)).reshape(B, N, BRANCH_W)
    yb, yb_c = ssm_branch(bz, bx, bdt, bzc, bxc, bdtc, conv_w, conv_b, dt_bias, a_log, d_skip, g_ssm, need_ctx)
    qs = apply_rope(sq.reshape(B, N, SW_HEADS, SW_DIM), cos, sin)
    ks = apply_rope(sk.reshape(B, N, SW_KV_HEADS, SW_DIM), cos, sin)
    vs = sv.reshape(B, N, SW_KV_HEADS, SW_DIM)
    ksc = skc.reshape(B, L, SW_KV_HEADS, SW_DIM)
    vsc = svc.reshape(B, L, SW_KV_HEADS, SW_DIM)
    ys = window_attn_latent(qs, ks, vs, ksc, vsc, sink)
    knc = nkc.reshape(B, L, NA_HEADS, NA_DIM)
    vnc = nvc.reshape(B, L, NA_HEADS, NA_DIM)
    yn = neighbourhood_attn_latent(nq.reshape(B, N, NA_HEADS, NA_DIM), nk.reshape(B, N, NA_HEADS, NA_DIM),
                                   nv.reshape(B, N, NA_HEADS, NA_DIM), knc, vnc, rpb)
    y = merge([ya, yb, ys, yn], gate, w_branch, w_out)
    if not need_ctx:
        return y, None
    ya_c = (rmsnorm(diff_core(aqc.reshape(B, L, DA_HEADS, 2, DA_DIM), kac, vac, lam), g_subln)
            * (1.0 - lam_init)).reshape(B, L, BRANCH_W)
    ys_c = ctx_attend(sqc.reshape(B, L, SW_HEADS, SW_DIM), ksc, vsc, sink)
    yn_c = ctx_attend(nqc.reshape(B, L, NA_HEADS, NA_DIM), knc, vnc)
    y_c = merge([ya_c, yb_c, ys_c, yn_c], gatec, w_branch, w_out)
    return y, y_c


def ffn(t, w1, w2):
    return jnp.square(jax.nn.relu(t @ w1)) @ w2


def setup_inputs(seed: int = 0) -> dict:
    key = jax.random.key(seed)
    ks = iter(jax.random.split(key, 40))
    nrm = lambda shape, s: jax.random.normal(next(ks), shape, jnp.float32) * s
    Lr, D = DEPTH, D_MODEL
    dt0 = jnp.exp(jax.random.uniform(next(ks), (Lr, 2, SSM_HEADS), jnp.float32)
                  * (math.log(0.1) - math.log(0.001)) + math.log(0.001))
    return {
        'x': nrm((BATCH, SEQ, D), 1.0),
        'c': nrm((BATCH, D), 1.0),
        'ctx': nrm((BATCH, CTX_LEN, D), 1.0),
        'c_ctx': nrm((D,), 1.0),
        'w_mod': nrm((Lr, D, 6 * D), 0.5 * D ** -0.5),
        'b_mod': nrm((Lr, 6 * D), 0.02),
        'g_pre_mix': 1.0 + nrm((Lr, D), 0.05),
        'g_post_mix': 1.0 + nrm((Lr, D), 0.05),
        'g_pre_mlp': 1.0 + nrm((Lr, D), 0.05),
        'g_post_mlp': 1.0 + nrm((Lr, D), 0.05),
        'w_in': nrm((Lr, D, IN_COLS), D ** -0.5),
        'lam_q1': nrm((Lr, DA_DIM), 0.1),
        'lam_k1': nrm((Lr, DA_DIM), 0.1),
        'lam_q2': nrm((Lr, DA_DIM), 0.1),
        'lam_k2': nrm((Lr, DA_DIM), 0.1),
        'g_subln': 1.0 + nrm((Lr, 2 * DA_DIM), 0.05),
        'conv_w': nrm((Lr, SSM_CONV, SSM_XBC), SSM_CONV ** -0.5),
        'conv_b': nrm((Lr, SSM_XBC), 0.02),
        'dt_bias': dt0 + jnp.log(-jnp.expm1(-dt0)),
        'a_log': jnp.log(jax.random.uniform(next(ks), (Lr, 2, SSM_HEADS), jnp.float32, 1.0, 16.0)),
        'd_skip': 1.0 + nrm((Lr, SSM_HEADS), 0.1),
        'g_ssm': 1.0 + nrm((Lr, SSM_INNER), 0.05),
        'sink': nrm((Lr, SW_HEADS), 0.5),
        'rpb': nrm((Lr, NA_HEADS, 2 * NA_ROWS - 1, 2 * NA_COLS - 1), 0.1),
        'w_branch': nrm((Lr, N_BRANCH, BRANCH_W, D), BRANCH_W ** -0.5),
        'w_out': nrm((Lr, D, D), D ** -0.5),
        'w_ff1': nrm((Lr, D, D_FF), D ** -0.5),
        'w_ff2': nrm((Lr, D_FF, D), D_FF ** -0.5),
    }


def reference(x, c, ctx, c_ctx, w_mod, b_mod, g_pre_mix, g_post_mix, g_pre_mlp, g_post_mlp, w_in,
              lam_q1, lam_k1, lam_q2, lam_k2, g_subln, conv_w, conv_b, dt_bias, a_log, d_skip, g_ssm,
              sink, rpb, w_branch, w_out, w_ff1, w_ff2):
    B, N, D = x.shape
    cos, sin = axial_rope(N, DA_DIM)
    cx = ctx
    for l in range(DEPTH):
        need_ctx = l < DEPTH - 1
        lam_init = 0.8 - 0.6 * math.exp(-0.3 * l)
        mod = (jax.nn.silu(c) @ w_mod[l] + b_mod[l]).reshape(B, 6, 1, D)
        modc = (jax.nn.silu(c_ctx) @ w_mod[l] + b_mod[l]).reshape(6, D)
        h = modulate(rmsnorm(x, g_pre_mix[l]), mod[:, 0], mod[:, 1])
        hc = modulate(rmsnorm(cx, g_pre_mix[l]), modc[0], modc[1])
        y, y_c = mixer(h, hc, cos, sin, lam_init, need_ctx, w_in[l], lam_q1[l], lam_k1[l], lam_q2[l], lam_k2[l],
                       g_subln[l], conv_w[l], conv_b[l], dt_bias[l], a_log[l], d_skip[l], g_ssm[l], sink[l],
                       rpb[l], w_branch[l], w_out[l])
        x = x + mod[:, 2] * rmsnorm(y, g_post_mix[l])
        h = modulate(rmsnorm(x, g_pre_mlp[l]), mod[:, 3], mod[:, 4])
        x = x + mod[:, 5] * rmsnorm(ffn(h, w_ff1[l], w_ff2[l]), g_post_mlp[l])
        if need_ctx:
            cx = cx + modc[2] * rmsnorm(y_c, g_post_mix[l])
            hc = modulate(rmsnorm(cx, g_pre_mlp[l]), modc[3], modc[4])
            cx = cx + modc[5] * rmsnorm(ffn(hc, w_ff1[l], w_ff2[l]), g_post_mlp[l])
    return x
```

```cpp
#include <hip/hip_runtime.h>
#include <hip/hip_cooperative_groups.h>
#include <cstdio>
#include <cstdint>
namespace cg = cooperative_groups;

constexpr int D = 2048, NB = 2, SEQ = 8192, CTXL = 256, DFF = 8192, NLAYER = 2;
constexpr int MLAT = NB * SEQ, MCTX = NB * CTXL, MALL = MLAT + MCTX;
constexpr int INC = 13584, LDP = 13824;
constexpr int C_AQ = 0, C_AK = 512, C_AV = 1024, C_BZ = 1536, C_BX = 2048, C_BDT = 3072, C_SQ = 3088, C_SK = 3600, C_SV = 3728,
              C_NQ = 3856, C_NK = 4368, C_NV = 4880, C_GATE = 5392;
constexpr int NKEY = SEQ + CTXL;
constexpr int NVC = 1152;
constexpr int NCH = 66;
constexpr float EPS = 1e-6f;
constexpr float LOG2E = 1.4426950408889634f;

constexpr size_t MiB = 1u << 20;
constexpr size_t WS_MOD = 0;
constexpr size_t WS_LAM = 512 * 1024;
constexpr size_t WS_DEC = 576 * 1024;
constexpr size_t WS_SSQ = 640 * 1024;
constexpr size_t WS_BAR = 768 * 1024;
constexpr size_t WS_COS = 1 * MiB, WS_SIN = 2 * MiB;
constexpr size_t WS_CX = 4 * MiB;
constexpr size_t WS_WT = 8 * MiB;
constexpr size_t WT_IN = 0, WT_BR = (size_t)LDP * D * 2, WT_OUT = WT_BR + (size_t)4 * D * 512 * 2, WT_F1 = WT_OUT + (size_t)D * D * 2, WT_F2 = WT_F1 + (size_t)DFF * D * 2;
constexpr size_t WS_ACT = 142 * MiB;
constexpr size_t WS_P = 208 * MiB;
constexpr size_t WS_FH = WS_P;
constexpr size_t WS_Y = WS_P + 264 * MiB;
constexpr size_t WS_YS = 654 * MiB;
constexpr size_t WS_VT = 720 * MiB;
constexpr size_t WS_HPB = 758 * MiB;
constexpr size_t WS_YC = 791 * MiB;
constexpr size_t WS_END = 795 * MiB;
static_assert(WT_F2 + (size_t)D * DFF * 2 == 134 * MiB, "weights");
static_assert((size_t)MALL * D * 2 == 66 * MiB, "act");
static_assert(WS_P + (size_t)MALL * LDP * 2 <= WS_YS, "P");
static_assert(WS_Y + (size_t)MALL * D * 4 <= WS_YS, "Y");
static_assert(WS_VT + (size_t)NB * NVC * NKEY * 2 <= WS_HPB, "VT");
static_assert((size_t)NB * NCH * 2 * 8 * 64 * 128 * 4 == 66 * MiB, "states alias ACT exactly");

constexpr int LDS_BYTES = 147456;
constexpr int LDS_BARST = LDS_BYTES - 64;
constexpr int NT = 512;

#define LAS __attribute__((address_space(3)))
#define GAS __attribute__((address_space(1)))
typedef unsigned short bf16;
typedef short bf16x8 __attribute__((ext_vector_type(8)));
typedef short bf16x4 __attribute__((ext_vector_type(4)));
typedef float f32x4 __attribute__((ext_vector_type(4)));
typedef float f32x2 __attribute__((ext_vector_type(2)));
typedef unsigned u32x4 __attribute__((ext_vector_type(4)));
typedef unsigned u32x2 __attribute__((ext_vector_type(2)));

__device__ __forceinline__ float bf2f(unsigned v) { return __uint_as_float(v << 16); }
__device__ __forceinline__ unsigned f2bf(float f) { unsigned u = __float_as_uint(f); return (u + 0x7fffu + ((u >> 16) & 1u)) >> 16; }
__device__ __forceinline__ unsigned pk2(float lo, float hi) { unsigned r; asm volatile("v_cvt_pk_bf16_f32 %0, %1, %2" : "=v"(r) : "v"(lo), "v"(hi)); return r; }
__device__ __forceinline__ float lo16(unsigned w) { return __uint_as_float(w << 16); }
__device__ __forceinline__ float hi16(unsigned w) { return __uint_as_float(w & 0xffff0000u); }
__device__ __forceinline__ float ex2(float x) { return __builtin_amdgcn_exp2f(x); }
__device__ __forceinline__ float sigmoidf_(float x) { return 1.0f / (1.0f + __expf(-x)); }
__device__ __forceinline__ float siluf_(float x) { return x / (1.0f + __expf(-x)); }
__device__ __forceinline__ float wave_sum(float v) {
#pragma unroll
    for (int o = 1; o < 64; o <<= 1) v += __shfl_xor(v, o);
    return v;
}

__device__ __forceinline__ int tid_opaque() { int t = threadIdx.x; asm volatile("" : "+v"(t)); return t; }
__device__ __forceinline__ int sgpr_opaque(int v) { asm volatile("" : "+s"(v)); return v; }

struct Params {
    const float* in[28];
    float* out;
    unsigned char* ws;
};
enum { I_X = 0, I_C, I_CTX, I_CCTX, I_WMOD, I_BMOD, I_GPREMIX, I_GPOSTMIX, I_GPREMLP, I_GPOSTMLP, I_WIN, I_LQ1, I_LK1, I_LQ2, I_LK2, I_GSUBLN,
       I_CONVW, I_CONVB, I_DTBIAS, I_ALOG, I_DSKIP, I_GSSM, I_SINK, I_RPB, I_WBR, I_WOUT, I_WFF1, I_WFF2 };
#define XB_TMO      128
#define XB_XCNT(j)  (256  + 64 * (j))
#define XB_XSUB(j)  (1280 + 64 * (j))
#define XB_XGEN(j)  (2304 + 64 * (j))
#define XB_TOP      3328
#define XB_TOPGEN   3392
#define XCD_BAR_WORDS 3456
#define XB_SPIN_CAP (1u << 18)

__device__ __forceinline__ unsigned xb_ld(unsigned* p)              { return __hip_atomic_load(p, __ATOMIC_RELAXED, __HIP_MEMORY_SCOPE_AGENT); }
__device__ __forceinline__ unsigned xb_add(unsigned* p, unsigned v) { return __hip_atomic_fetch_add(p, v, __ATOMIC_RELAXED, __HIP_MEMORY_SCOPE_AGENT); }
__device__ __forceinline__ unsigned xb_xcc_id() { return (unsigned)__builtin_amdgcn_s_getreg((3 << 11) | 20) & 0xFu; }
#define XB_SPIN(cond, bar) do { unsigned _sp = 0; while (cond) { __builtin_amdgcn_s_sleep(1); \
    if ((++_sp & 255u) == 0u) { if (xb_ld(&(bar)[XB_TMO])) break; if (_sp > XB_SPIN_CAP) { atomicAdd(&(bar)[XB_TMO], 1u); break; } } } } while (0)

struct XcdBarrier {
    unsigned* bar; unsigned x;
    volatile LAS unsigned* st;
};

__device__ __forceinline__ XcdBarrier xcd_barrier_post(unsigned* bar, volatile LAS unsigned* st) {
    XcdBarrier b; b.bar = bar; b.x = xb_xcc_id(); b.st = st;
    if (threadIdx.x == 0) (void)xb_add(&bar[XB_XCNT(b.x)], 1u);
    return b;
}
__device__ __forceinline__ void xcd_barrier_complete(unsigned* bar, unsigned x, unsigned& nloc, unsigned& nx) {
    const unsigned G = gridDim.x * gridDim.y * gridDim.z;
    unsigned sum, cnt, mine, sp = 0u;
    for (;;) {
        sum = 0u; cnt = 0u; mine = 0u;
#pragma unroll
        for (unsigned j = 0; j < 16; ++j) { const unsigned c = xb_ld(&bar[XB_XCNT(j)]); sum += c; cnt += (c > 0u) ? 1u : 0u; mine = (j == x) ? c : mine; }
        if (sum == G) break;
        __builtin_amdgcn_s_sleep(1);
        if ((++sp & 255u) == 0u) { if (xb_ld(&bar[XB_TMO])) break; if (sp > XB_SPIN_CAP) { atomicAdd(&bar[XB_TMO], 1u); break; } }
    }
    nloc = mine > 0u ? mine : 1u; nx = cnt > 0u ? cnt : 1u;
}

__device__ __forceinline__ void xcd_barrier(const XcdBarrier& b) {
    asm volatile("s_waitcnt vmcnt(0)" ::: "memory");
    __syncthreads();
    if (threadIdx.x == 0) {
        unsigned* bar = b.bar;
        __builtin_amdgcn_s_waitcnt(0);
        unsigned nloc = b.st[0], nx = b.st[1];
        if (nloc == 0u) { xcd_barrier_complete(bar, b.x, nloc, nx); b.st[0] = nloc; b.st[1] = nx; }
        const unsigned old = xb_add(&bar[XB_XSUB(b.x)], 1u);
        const unsigned gen = old / nloc;
        if (old + 1u == (gen + 1u) * nloc) {
            __builtin_amdgcn_fence(__ATOMIC_RELEASE, "agent");
            asm volatile("s_waitcnt vmcnt(0)" ::: "memory");
            const unsigned og = xb_add(&bar[XB_TOP], 1u);
            const unsigned tg = og / nx;
            if (og + 1u == (tg + 1u) * nx) xb_add(&bar[XB_TOPGEN], 1u);
            else XB_SPIN(xb_ld(&bar[XB_TOPGEN]) == tg, bar);
            __builtin_amdgcn_fence(__ATOMIC_ACQUIRE, "agent");
            xb_add(&bar[XB_XGEN(b.x)], 1u);
            asm volatile("s_waitcnt vmcnt(0)" ::: "memory");
        } else {
            XB_SPIN(xb_ld(&bar[XB_XGEN(b.x)]) == gen, bar);
            __builtin_amdgcn_fence(__ATOMIC_ACQUIRE, "agent");
            asm volatile("s_waitcnt vmcnt(0)" ::: "memory");
        }
    }
    __syncthreads();
}
namespace pg8 {
#define PG8_LAS __attribute__((address_space(3)))
typedef unsigned short bf16_t;
typedef short bf16x8 __attribute__((ext_vector_type(8)));
typedef float f32x4 __attribute__((ext_vector_type(4)));
typedef unsigned u32x4 __attribute__((ext_vector_type(4)));
constexpr int BM = 256, BK = 64, HALF = 128, HTB = HALF * BK * 2  , STAGE_BYTES = 8 * HTB, NXCD = 8, WGM = 8;

__host__ __device__ __forceinline__ int lds_byte(int r, int c) { const int st = (r >> 4) * 2 + (c >> 5), rr = r & 15, cc = c & 31, ob = rr * 64 + cc * 2; return st * 1024 + (ob ^ (((ob >> 9) & 1) << 5)); }
__host__ __device__ __forceinline__ void stage_rc(int b, int& R, int& C) { const int st = b / 1024, sb = b % 1024, swz = sb ^ (((sb >> 9) & 1) << 5); R = (st >> 1) * 16 + swz / 64; C = (st & 1) * 32 + (swz % 64) / 2; }
__host__ __device__ __forceinline__ int perm32(int rho) { const int n = rho >> 4, i = rho & 15; return 8 * (i >> 2) + 4 * n + (i & 3); }

struct Unit { int pm, pn, z; };
struct Gemm { const bf16_t* A; const bf16_t* Bt; int M, N, K; size_t zA, zB; int ld; };

struct StaticOrder {
    int nM, nN, nwg, G, c;
    __host__ __device__ void init(int M, int N, int G_, int c_) { nM = M / BM; nN = N / BM; nwg = nM * nN; G = G_; c = c_; }
    __host__ __device__ bool next(int i, Unit& u) const {
        const long L = (long)i * G + c; if (L >= nwg) return false;
        int wgid = (int)L; { const int q = nwg / NXCD, r = nwg % NXCD, xcd = wgid % NXCD, off = wgid / NXCD; wgid = (xcd < r ? xcd * (q + 1) : r * (q + 1) + (xcd - r) * q) + off; }
        const int nig = WGM * nN, gid = wgid / nig, fm = gid * WGM, gsz = (nM - fm) < WGM ? (nM - fm) : WGM;
        u.pm = fm + ((wgid % nig) % gsz); u.pn = (wgid % nig) / gsz; u.z = 0; return true;
    }
    __device__ __forceinline__ void a_ready(const Unit&) const {}
    __device__ __forceinline__ void done(const Unit&) const {}
};


struct MergeOrder {
    StaticOrder base;
    __host__ __device__ void init(int M, int N, int G_, int c_) { base.init(M, N, G_, c_); }
    __host__ __device__ bool next(int i, Unit& u) const { if (!base.next(i >> 2, u)) return false; u.z = i & 3; return true; }
    __device__ __forceinline__ void a_ready(const Unit&) const {}
    __device__ __forceinline__ void done(const Unit&) const {}
};

struct SplitOrder {
    int nN, nunits, G, c;
    __host__ __device__ void init(int M, int N, int G_, int c_) { nN = N / BM; nunits = (M / BM) * nN * 4; G = G_; c = c_; }
    __host__ __device__ bool next(int i, Unit& u) const { const int L = i * G + c; if (L >= nunits) return false; const int t = L >> 2; u.z = L & 3; u.pm = t / nN; u.pn = t % nN; return true; }
    __device__ __forceinline__ void a_ready(const Unit&) const {}
    __device__ __forceinline__ void done(const Unit&) const {}
};

template <class E, class = void> struct EpiChain { static constexpr bool value = false; };
template <class E> struct EpiChain<E, decltype((void)E::CHAIN)> { static constexpr bool value = E::CHAIN; };

__device__ __forceinline__ unsigned cvt_pk_bf16(float lo, float hi) { unsigned r; asm volatile("v_cvt_pk_bf16_f32 %0, %1, %2" : "=v"(r) : "v"(lo), "v"(hi)); return r; }

template <int ACT  > struct EpiBf {
    static constexpr bool PERM = true, AFTER_DRAIN = false;
    bf16_t* O; int ldc;
    __device__ __forceinline__ void operator()(const f32x4 (&acc)[2][2][4][2], const Unit& u, int wr, int wc, int fr, int fq) const {
        const int row0 = u.pm * BM + wr * 64 + fr, col0 = u.pn * BM + wc * 32 + 8 * fq;
#pragma unroll
        for (int ai = 0; ai < 2; ++ai)
#pragma unroll
            for (int m = 0; m < 4; ++m) { bf16_t* rowp = O + (size_t)(row0 + ai * HALF + m * 16) * ldc + col0;
#pragma unroll
                for (int bj = 0; bj < 2; ++bj) { f32x4 v0 = acc[ai][bj][m][0], v1 = acc[ai][bj][m][1];
                    if (ACT == 2) {
#pragma unroll
                        for (int e = 0; e < 4; ++e) { float a = fmaxf(v0[e], 0.f), b = fmaxf(v1[e], 0.f); v0[e] = a * a; v1[e] = b * b; } }
                    u32x4 w; w.x = cvt_pk_bf16(v0[0], v0[1]); w.y = cvt_pk_bf16(v0[2], v0[3]); w.z = cvt_pk_bf16(v1[0], v1[1]); w.w = cvt_pk_bf16(v1[2], v1[3]);
                    *(u32x4*)(rowp + bj * HALF) = w; } }
    }
};
struct EpiF32 {
    static constexpr bool PERM = true, AFTER_DRAIN = false;
    float* O; int ldc;
    __device__ __forceinline__ void operator()(const f32x4 (&acc)[2][2][4][2], const Unit& u, int wr, int wc, int fr, int fq) const {
        const int row0 = u.pm * BM + wr * 64 + fr, col0 = u.pn * BM + wc * 32 + 8 * fq;
#pragma unroll
        for (int ai = 0; ai < 2; ++ai)
#pragma unroll
            for (int m = 0; m < 4; ++m) { float* rowp = O + (size_t)(row0 + ai * HALF + m * 16) * ldc + col0;
#pragma unroll
                for (int bj = 0; bj < 2; ++bj) { *(f32x4*)(rowp + bj * HALF) = acc[ai][bj][m][0]; *(f32x4*)(rowp + bj * HALF + 4) = acc[ai][bj][m][1]; } }
    }
};
struct EpiMerge {
    static constexpr bool PERM = true, AFTER_DRAIN = false, CHAIN = true;
    const bf16_t* P; int ldp; int gcol; bf16_t* O; int ldc; const float* ssq;
    __device__ __forceinline__ void chain(f32x4 (&acc)[2][2][4][2], const Unit& u, int wr, int wc, int fr, int fq) const {
        const int row0 = u.pm * BM + wr * 64 + fr, col0 = u.pn * BM + wc * 32 + 8 * fq; const int z = u.z;
        constexpr float L2E = 1.4426950408889634f;
#pragma unroll
        for (int aim = 0; aim < 4; ++aim) { const int ai = aim >> 1, m0 = (aim & 1) * 2;
            u32x4 gz[4][2], gn[4][2]; float sq[4];
#pragma unroll
            for (int m = m0; m < m0 + 2; ++m) { const int row = row0 + ai * HALF + m * 16; const bf16_t* gp = P + (size_t)row * ldp + gcol + z * 2048 + col0;
                sq[m] = z < 2 ? ssq[row] : 512.0f;
#pragma unroll
                for (int bj = 0; bj < 2; ++bj) { gz[m][bj] = *(const u32x4*)(gp + bj * HALF); gn[m][bj] = z < 3 ? *(const u32x4*)(gp + 2048 + bj * HALF) : (u32x4){0u, 0u, 0u, 0u}; } }
#pragma unroll
            for (int m = m0; m < m0 + 2; ++m) { const int row = row0 + ai * HALF + m * 16; bf16_t* rowp = O + (size_t)row * ldc + col0;
                float rsf = 1.f; if (z < 2) { const float rs = 1.0f / sqrtf(sq[m] * (1.0f / 512.0f) + 1e-6f); rsf = z == 1 ? rs : 1.0f / rs; }
#pragma unroll
                for (int bj = 0; bj < 2; ++bj) {
                    const u32x4 gw = gz[m][bj];
                    const float g[8] = { __uint_as_float(gw.x << 16), __uint_as_float(gw.x & 0xffff0000u), __uint_as_float(gw.y << 16), __uint_as_float(gw.y & 0xffff0000u),
                                         __uint_as_float(gw.z << 16), __uint_as_float(gw.z & 0xffff0000u), __uint_as_float(gw.w << 16), __uint_as_float(gw.w & 0xffff0000u) };
                    float f[8];
#pragma unroll
                    for (int e = 0; e < 8; ++e) f[e] = __builtin_amdgcn_rcpf(1.0f + __builtin_amdgcn_exp2f(-L2E * g[e])) * rsf;
                    if (z < 3) {
                        const u32x4 nw = gn[m][bj];
                        const float gnx[8] = { __uint_as_float(nw.x << 16), __uint_as_float(nw.x & 0xffff0000u), __uint_as_float(nw.y << 16), __uint_as_float(nw.y & 0xffff0000u),
                                               __uint_as_float(nw.z << 16), __uint_as_float(nw.z & 0xffff0000u), __uint_as_float(nw.w << 16), __uint_as_float(nw.w & 0xffff0000u) };
#pragma unroll
                        for (int e = 0; e < 8; ++e) f[e] *= (1.0f + __builtin_amdgcn_exp2f(-L2E * gnx[e]));
#pragma unroll
                        for (int e = 0; e < 4; ++e) { acc[ai][bj][m][0][e] *= f[e]; acc[ai][bj][m][1][e] *= f[4 + e]; }
                    } else {
                        const f32x4 v0 = acc[ai][bj][m][0], v1 = acc[ai][bj][m][1];
                        u32x4 w; w.x = cvt_pk_bf16(v0[0] * f[0], v0[1] * f[1]); w.y = cvt_pk_bf16(v0[2] * f[2], v0[3] * f[3]); w.z = cvt_pk_bf16(v1[0] * f[4], v1[1] * f[5]); w.w = cvt_pk_bf16(v1[2] * f[6], v1[3] * f[7]);
                        *(u32x4*)(rowp + bj * HALF) = w;
                    }
                } }
        }
    }
    __device__ __forceinline__ void operator()(const f32x4 (&)[2][2][4][2], const Unit&, int, int, int, int) const {}
};
struct EpiAtomicF32 {
    static constexpr bool PERM = true, AFTER_DRAIN = false;
    float* O; int ldc;
    __device__ __forceinline__ void operator()(const f32x4 (&acc)[2][2][4][2], const Unit& u, int wr, int wc, int fr, int fq) const {
        const int row0 = u.pm * BM + wr * 64 + fr, col0 = u.pn * BM + wc * 32 + 8 * fq;
#pragma unroll
        for (int ai = 0; ai < 2; ++ai)
#pragma unroll
            for (int m = 0; m < 4; ++m) { float* rowp = O + (size_t)(row0 + ai * HALF + m * 16) * ldc + col0;
#pragma unroll
                for (int bj = 0; bj < 2; ++bj)
#pragma unroll
                    for (int e2 = 0; e2 < 4; ++e2) { unsafeAtomicAdd(rowp + bj * HALF + e2, acc[ai][bj][m][0][e2]); unsafeAtomicAdd(rowp + bj * HALF + 4 + e2, acc[ai][bj][m][1][e2]); } }
    }
};
template <class Epi, class Sched, bool ALIGN_EPI = false, bool SP2 = false>
__device__ __forceinline__ void gemm_phase(PG8_LAS unsigned char* lds, const Gemm g, const Sched& S, const Epi& E) {
    const int tid = tid_opaque(), wid = __builtin_amdgcn_readfirstlane(tid >> 6), lane = tid & 63, wr = wid >> 2, wc = wid & 3, fr = lane & 15, fq = lane >> 4;
    const int K = g.K, nt = K / BK, LD = g.ld ? g.ld : g.K;
    unsigned voffA[2], voffB[2];
#pragma unroll
    for (int i = 0; i < 2; ++i) { int R, C; stage_rc(tid * 16 + i * 8192, R, C); const int Rb = Epi::PERM ? ((R & ~31) + perm32(R & 31)) : R;
        voffA[i] = (unsigned)(R * LD + C) * 2u; voffB[i] = (unsigned)(Rb * LD + C) * 2u; }
    const size_t kstep = (size_t)(BK * 2);
    const size_t hstep = (size_t)HALF * LD * 2;
    const size_t tstep = 2 * hstep;
    const unsigned ldsw = (unsigned)wid * 1024u;
    const int aoff = lds_byte(wr * 64 + fr, fq * 8), boff = lds_byte(wc * 32 + fr, fq * 8);
#define PG8_SA(b, h) (((b) * 2 + (h)) * HTB)
#define PG8_SB(b, h) ((4 + (b) * 2 + (h)) * HTB)
#define PG8_STAGE(bufoff, gbase, voff) do { _Pragma("unroll") for (int _i = 0; _i < 2; ++_i) \
        __builtin_amdgcn_global_load_lds((const unsigned*)((const char*)(gbase) + (voff)[_i]), (PG8_LAS unsigned*)(lds + (bufoff) + ldsw + _i * 8192), 16, 0, 0); } while (0)
#define PG8_LDA(dst, b, h) do { _Pragma("unroll") for (int m = 0; m < 4; ++m) _Pragma("unroll") for (int k = 0; k < 2; ++k) dst[m][k] = *(const PG8_LAS bf16x8*)(lds + PG8_SA(b, h) + aoff + m * 2048 + k * 1024); } while (0)
#define PG8_LDB(dst, b, h) do { _Pragma("unroll") for (int n = 0; n < 2; ++n) _Pragma("unroll") for (int k = 0; k < 2; ++k) dst[n][k] = *(const PG8_LAS bf16x8*)(lds + PG8_SB(b, h) + boff + n * 2048 + k * 1024); } while (0)
#define PG8_MMA(ai, bj, At, Bt) do { __builtin_amdgcn_s_setprio(1); _Pragma("unroll") for (int m = 0; m < 4; ++m) _Pragma("unroll") for (int n = 0; n < 2; ++n) _Pragma("unroll") for (int k = 0; k < 2; ++k) \
        acc[ai][bj][m][n] = __builtin_amdgcn_mfma_f32_16x16x32_bf16(Bt[n][k], At[m][k], acc[ai][bj][m][n], 0, 0, 0); __builtin_amdgcn_s_setprio(0); } while (0)
#define PG8_WAIT_V(n) asm volatile("s_waitcnt vmcnt(" #n ")" ::: "memory")
#define PG8_WAIT_L(n) asm volatile("s_waitcnt lgkmcnt(" #n ")" ::: "memory")
#define PG8_BAR __builtin_amdgcn_s_barrier()
#define PG8_SCHED __builtin_amdgcn_sched_barrier(0)
    Unit cur, nxt; int ui = 0;
    if (!S.next(0, cur)) return;
    f32x4 acc[2][2][4][2];
#pragma unroll
    for (int a = 0; a < 2; ++a)
#pragma unroll
        for (int b = 0; b < 2; ++b)
#pragma unroll
            for (int m = 0; m < 4; ++m)
#pragma unroll
                for (int n = 0; n < 2; ++n) acc[a][b][m][n] = (f32x4){0.f, 0.f, 0.f, 0.f};
    bf16x8 At[4][2], B0[2][2], B1[2][2];
    const char* cA = (const char*)g.A + (size_t)cur.pm * tstep + (size_t)cur.z * g.zA; const char* cB = (const char*)g.Bt + (size_t)cur.pn * tstep + (size_t)cur.z * g.zB;
    S.a_ready(cur);
    if constexpr (SP2) {
        PG8_STAGE(PG8_SB(0, 0), cB, voffB); PG8_STAGE(PG8_SB(0, 1), cB + hstep, voffB); PG8_STAGE(PG8_SA(0, 0), cA, voffA); PG8_STAGE(PG8_SA(0, 1), cA + hstep, voffA);
        if (wr == 1) PG8_BAR;
        PG8_WAIT_V(2); PG8_BAR;
        PG8_STAGE(PG8_SB(1, 0), cB + kstep, voffB); PG8_STAGE(PG8_SA(1, 0), cA + kstep, voffA); PG8_STAGE(PG8_SB(1, 1), cB + hstep + kstep, voffB);
        PG8_WAIT_V(6); PG8_BAR;
    } else {
        PG8_STAGE(PG8_SB(0, 0), cB, voffB); PG8_STAGE(PG8_SA(0, 0), cA, voffA); PG8_STAGE(PG8_SB(0, 1), cB + hstep, voffB); PG8_STAGE(PG8_SA(0, 1), cA + hstep, voffA);
        if (wr == 1) PG8_BAR;
        PG8_WAIT_V(4); PG8_BAR;
        PG8_STAGE(PG8_SB(1, 0), cB + kstep, voffB); PG8_STAGE(PG8_SA(1, 0), cA + kstep, voffA); PG8_STAGE(PG8_SB(1, 1), cB + hstep + kstep, voffB);
        PG8_WAIT_V(6); PG8_BAR;
    }
    for (;;) {
        const bool has_next = S.next(ui + 1, nxt);
        const char* nA = has_next ? (const char*)g.A + (size_t)nxt.pm * tstep + (size_t)nxt.z * g.zA : cA; const char* nB = has_next ? (const char*)g.Bt + (size_t)nxt.pn * tstep + (size_t)nxt.z * g.zB : cB;
        for (int t = 0; t < nt; t += 2) {
            const bool last = (t == nt - 2);
            const char* a1 = cA + (size_t)(t + 1) * kstep;
            const char* a2 = last ? nA : cA + (size_t)(t + 2) * kstep; const char* b2 = last ? nB : cB + (size_t)(t + 2) * kstep;
            const char* a3 = a2 + kstep; const char* b3 = b2 + kstep;
            if (last && has_next) S.a_ready(nxt);
            if constexpr (SP2) {
            PG8_LDB(B0, 0, 0); PG8_LDB(B1, 0, 1); PG8_SCHED; PG8_LDA(At, 0, 0); PG8_STAGE(PG8_SA(1, 1), a1 + hstep, voffA);
            PG8_WAIT_V(8); PG8_WAIT_L(0); PG8_BAR; PG8_MMA(0, 0, At, B0); PG8_MMA(0, 1, At, B1); PG8_BAR; PG8_SCHED;
            PG8_LDA(At, 0, 1); PG8_STAGE(PG8_SB(0, 0), b2, voffB); PG8_STAGE(PG8_SB(0, 1), b2 + hstep, voffB); PG8_STAGE(PG8_SA(0, 0), a2, voffA);
            PG8_WAIT_V(8); PG8_WAIT_L(0); PG8_BAR; PG8_MMA(1, 0, At, B0); PG8_MMA(1, 1, At, B1); PG8_BAR; PG8_SCHED;
            PG8_LDB(B0, 1, 0); PG8_LDB(B1, 1, 1); PG8_SCHED; PG8_LDA(At, 1, 0); PG8_STAGE(PG8_SA(0, 1), a2 + hstep, voffA);
            PG8_WAIT_V(8); PG8_WAIT_L(0); PG8_BAR; PG8_MMA(0, 0, At, B0); PG8_MMA(0, 1, At, B1); PG8_BAR; PG8_SCHED;
            PG8_LDA(At, 1, 1); PG8_STAGE(PG8_SB(1, 0), b3, voffB); PG8_STAGE(PG8_SB(1, 1), b3 + hstep, voffB); PG8_STAGE(PG8_SA(1, 0), a3, voffA);
            PG8_WAIT_V(8); PG8_WAIT_L(0); PG8_BAR; PG8_MMA(1, 0, At, B0); PG8_MMA(1, 1, At, B1); PG8_BAR; PG8_SCHED;
            } else {
            PG8_LDB(B0, 0, 0); PG8_SCHED; PG8_LDA(At, 0, 0); PG8_STAGE(PG8_SA(1, 1), a1 + hstep, voffA);
            PG8_WAIT_L(8); PG8_BAR; PG8_WAIT_L(0); PG8_MMA(0, 0, At, B0); PG8_BAR; PG8_SCHED;
            PG8_LDB(B1, 0, 1); PG8_STAGE(PG8_SB(0, 0), b2, voffB);
            PG8_BAR; PG8_WAIT_L(0); PG8_MMA(0, 1, At, B1); PG8_BAR;
            PG8_LDA(At, 0, 1); PG8_STAGE(PG8_SA(0, 0), a2, voffA);
            PG8_BAR; PG8_WAIT_L(0); PG8_MMA(1, 0, At, B0); PG8_BAR; PG8_SCHED;
            PG8_STAGE(PG8_SB(0, 1), b2 + hstep, voffB);
            PG8_WAIT_V(6); PG8_BAR; PG8_MMA(1, 1, At, B1); PG8_BAR;
            PG8_LDB(B0, 1, 0); PG8_SCHED; PG8_LDA(At, 1, 0); PG8_STAGE(PG8_SA(0, 1), a2 + hstep, voffA);
            PG8_WAIT_L(8); PG8_BAR; PG8_WAIT_L(0); PG8_MMA(0, 0, At, B0); PG8_BAR; PG8_SCHED;
            PG8_LDB(B1, 1, 1); PG8_STAGE(PG8_SB(1, 0), b3, voffB);
            PG8_BAR; PG8_WAIT_L(0); PG8_MMA(0, 1, At, B1); PG8_BAR;
            PG8_LDA(At, 1, 1); PG8_STAGE(PG8_SA(1, 0), a3, voffA);
            PG8_BAR; PG8_WAIT_L(0); PG8_MMA(1, 0, At, B0); PG8_BAR; PG8_SCHED;
            PG8_STAGE(PG8_SB(1, 1), b3 + hstep, voffB);
            PG8_WAIT_V(6); PG8_BAR; PG8_MMA(1, 1, At, B1); PG8_BAR;
            }
        }
        if constexpr (ALIGN_EPI) { if (wr == 0) PG8_BAR; }
        if constexpr (!Epi::AFTER_DRAIN) { if constexpr (EpiChain<Epi>::value) E.chain(acc, cur, wr, wc, fr, fq); else E(acc, cur, wr, wc, fr, fq); S.done(cur); }
        if (!has_next) break;
        if (!(EpiChain<Epi>::value && cur.z < 3)) {
#pragma unroll
        for (int a = 0; a < 2; ++a)
#pragma unroll
            for (int b = 0; b < 2; ++b)
#pragma unroll
                for (int m = 0; m < 4; ++m)
#pragma unroll
                    for (int n = 0; n < 2; ++n) acc[a][b][m][n] = (f32x4){0.f, 0.f, 0.f, 0.f};
        }
        cur = nxt; cA = nA; cB = nB; ++ui;
        if constexpr (ALIGN_EPI) { if (wr == 1) PG8_BAR; }
    }
    PG8_WAIT_V(0);
    if constexpr (!ALIGN_EPI) { if (wr == 0) PG8_BAR; }
    PG8_BAR;
    if constexpr (Epi::AFTER_DRAIN) { E.fused(acc, cur, wr, wc, fr, fq, lds, wid, lane); S.done(cur); }
#undef PG8_SA
#undef PG8_SB
#undef PG8_STAGE
#undef PG8_LDA
#undef PG8_LDB
#undef PG8_MMA
#undef PG8_WAIT_V
#undef PG8_WAIT_L
#undef PG8_BAR
#undef PG8_SCHED
}
}

constexpr int AT_PITCH = 160;
constexpr int AT_BUF = 256 * AT_PITCH;
constexpr int AT_RPB = 3 * AT_BUF;
__device__ __forceinline__ float max3f(float a, float b, float c) { float r; asm("v_max3_f32 %0, %1, %2, %3" : "=v"(r) : "v"(a), "v"(b), "v"(c)); return r; }
#define MFMA16(a, b, c) __builtin_amdgcn_mfma_f32_16x16x32_bf16((a), (b), (c), 0, 0, 0)

template <int NS, int DV, class MaskF>
__device__ __forceinline__ void attn_step(const LAS unsigned char* bufK, const LAS unsigned char* bufV, const int (&kslot)[NS], int vrow0, const bf16x8 (&qf)[NS][2],
                                          f32x4 (&o)[NS][DV / 16], float (&mrun)[NS], float (&lrun)[NS], bf16x8 (&pkp)[NS][2], bool masked, bool first, const MaskF& mf, int lane) {
    const int fr = lane & 15, g = lane >> 4;
    f32x4 s[NS][4];
#pragma unroll
    for (int st = 0; st < NS; ++st)
#pragma unroll
        for (int kt = 0; kt < 4; ++kt) {
            const LAS unsigned char* kp = bufK + (kslot[st] * 64 + kt * 16 + fr) * AT_PITCH + g * 16;
            const bf16x8 a0 = *(const LAS bf16x8*)kp, a1 = *(const LAS bf16x8*)(kp + 64);
            const float nm = -mrun[st];
            f32x4 z = {nm, nm, nm, nm};
            z = MFMA16(a0, qf[st][0], z); z = MFMA16(a1, qf[st][1], z);
            s[st][kt] = z;
        }
    if (masked) {
#pragma unroll
        for (int st = 0; st < NS; ++st)
#pragma unroll
            for (int kt = 0; kt < 4; ++kt)
#pragma unroll
                for (int i = 0; i < 4; ++i) s[st][kt][i] = mf(s[st][kt][i], st, kt * 16 + g * 4 + i);
    } else {
        __builtin_amdgcn_sched_group_barrier(0x100, 4, 0);
#pragma unroll
        for (int i = 0; i < NS * 8; ++i) { __builtin_amdgcn_sched_group_barrier(0x008, 1, 0); __builtin_amdgcn_sched_group_barrier(0x100, 1, 0); }
    }
    __builtin_amdgcn_sched_barrier(0);
    float mxs[NS]; bool slow = first;
#pragma unroll
    for (int st = 0; st < NS; ++st) {
        float mx = max3f(s[st][0][0], s[st][0][1], s[st][0][2]);
        mx = max3f(mx, s[st][0][3], s[st][1][0]); mx = max3f(mx, s[st][1][1], s[st][1][2]); mx = max3f(mx, s[st][1][3], s[st][2][0]);
        mx = max3f(mx, s[st][2][1], s[st][2][2]); mx = max3f(mx, s[st][2][3], s[st][3][0]); mx = max3f(mx, s[st][3][1], s[st][3][2]); mx = max3f(mx, s[st][3][3], mx);
        mx = max3f(mx, __shfl_xor(mx, 16), mx); mx = max3f(mx, __shfl_xor(mx, 32), mx);
        mxs[st] = mx; slow = slow || (mx > 8.0f);
    }
    if (__any(slow)) {
#pragma unroll
        for (int dt = 0; dt < DV / 16; ++dt)
#pragma unroll
            for (int j = 0; j < 2; ++j) {
                const bf16x8 va = *(const LAS bf16x8*)(bufV + (128 + vrow0 + dt * 16 + fr) * AT_PITCH + (j * 32 + g * 8) * 2);
#pragma unroll
                for (int st = 0; st < NS; ++st) o[st][dt] = MFMA16(va, pkp[st][j], o[st][dt]);
            }
#pragma unroll
        for (int st = 0; st < NS; ++st) {
            const float d = mxs[st] < -1e20f ? 0.f : (first ? mxs[st] : fmaxf(mxs[st], 0.f));
            mrun[st] += d; const float alpha = ex2(-d);
            lrun[st] *= alpha;
#pragma unroll
            for (int kt = 0; kt < 4; ++kt) s[st][kt] = s[st][kt] - d;
#pragma unroll
            for (int dt = 0; dt < DV / 16; ++dt) o[st][dt] = o[st][dt] * alpha;
            pkp[st][0] = (bf16x8){0, 0, 0, 0, 0, 0, 0, 0}; pkp[st][1] = pkp[st][0];
        }
    }
    __builtin_amdgcn_sched_barrier(0);
    {
        bf16x8 pkn[NS][2];
#pragma unroll
        for (int st = 0; st < NS; ++st) {
            float ps = 0.f;
#pragma unroll
            for (int kt = 0; kt < 4; ++kt)
#pragma unroll
                for (int i = 0; i < 4; ++i) { const float p = ex2(s[st][kt][i]); ps += p; s[st][kt][i] = p; }
            lrun[st] += ps;
#pragma unroll
            for (int j = 0; j < 2; ++j) {
                u32x4 w; w.x = pk2(s[st][2 * j][0], s[st][2 * j][1]); w.y = pk2(s[st][2 * j][2], s[st][2 * j][3]);
                w.z = pk2(s[st][2 * j + 1][0], s[st][2 * j + 1][1]); w.w = pk2(s[st][2 * j + 1][2], s[st][2 * j + 1][3]);
                pkn[st][j] = __builtin_bit_cast(bf16x8, w);
            }
        }
#pragma unroll
        for (int dt = 0; dt < DV / 16; ++dt)
#pragma unroll
            for (int j = 0; j < 2; ++j) {
                const bf16x8 va = *(const LAS bf16x8*)(bufV + (128 + vrow0 + dt * 16 + fr) * AT_PITCH + (j * 32 + g * 8) * 2);
#pragma unroll
                for (int st = 0; st < NS; ++st) o[st][dt] = MFMA16(va, pkp[st][j], o[st][dt]);
            }
#pragma unroll
        for (int st = 0; st < NS; ++st) { pkp[st][0] = pkn[st][0]; pkp[st][1] = pkn[st][1]; }
        __builtin_amdgcn_sched_group_barrier(0x100, 4, 0);
#pragma unroll
        for (int i = 0; i < NS * (DV / 16) * 2; ++i) {
            __builtin_amdgcn_sched_group_barrier(0x008, 1, 0);
            __builtin_amdgcn_sched_group_barrier(0x100, 1, 0);
            __builtin_amdgcn_sched_group_barrier(0x002, NS == 2 && DV == 128 ? 3 : 4, 0);
        }
    }
    __builtin_amdgcn_sched_barrier(0);
}
template <int NS, int DV>
__device__ __forceinline__ void attn_flush(const LAS unsigned char* bufV, int vrow0, f32x4 (&o)[NS][DV / 16], const bf16x8 (&pkp)[NS][2], int lane) {
    const int fr = lane & 15, g = lane >> 4;
#pragma unroll
    for (int dt = 0; dt < DV / 16; ++dt)
#pragma unroll
        for (int j = 0; j < 2; ++j) {
            const bf16x8 va = *(const LAS bf16x8*)(bufV + (128 + vrow0 + dt * 16 + fr) * AT_PITCH + (j * 32 + g * 8) * 2);
#pragma unroll
            for (int st = 0; st < NS; ++st) o[st][dt] = MFMA16(va, pkp[st][j], o[st][dt]);
        }
}

struct NoMask { __device__ __forceinline__ float operator()(float s, int, int) const { return s; } };
struct SwaMask { int qp, pos0; __device__ __forceinline__ float operator()(float s, int, int kl) const { const int d = pos0 + kl - qp; return (d <= 128 && d >= -128) ? s : -1e30f; } };
struct NaMask { int qc, cs, ro31; const LAS float* tab; __device__ __forceinline__ float operator()(float s, int, int kc) const {
    const bool ok = (kc >= cs) && (kc < cs + 16); const int co = kc - qc + 15; const float bias = tab[ro31 + (ok ? co : 15)]; return ok ? s + bias : -1e30f; } };

__device__ __forceinline__ void load_qfrag(const bf16* Pm, int row, int col, int g, float qscale, bf16x8 (&qf)[2]) {
#pragma unroll
    for (int kk = 0; kk < 2; ++kk) {
        const u32x4 w = *(const u32x4*)(Pm + (size_t)row * LDP + col + kk * 32 + g * 8);
        u32x4 r; r.x = pk2(lo16(w.x) * qscale, hi16(w.x) * qscale); r.y = pk2(lo16(w.y) * qscale, hi16(w.y) * qscale);
        r.z = pk2(lo16(w.z) * qscale, hi16(w.z) * qscale); r.w = pk2(lo16(w.w) * qscale, hi16(w.w) * qscale);
        qf[kk] = __builtin_bit_cast(bf16x8, r);
    }
}

template <int MODE>
__device__ __forceinline__ void attn_unit(const Params& p, int layer, LAS unsigned char* lds, int b, int hsel, int qb, bool ctxq) {
    constexpr int NS = MODE == 2 ? 1 : 2;
    constexpr int DV = MODE == 0 ? 128 : 64;
    constexpr int NBATCH = MODE == 1 ? 2 : 4;
    const int tid = tid_opaque(), lane = tid & 63, w = __builtin_amdgcn_readfirstlane(tid >> 6), fr = lane & 15, g = lane >> 4;
    const bf16* Pm = (const bf16*)(p.ws + WS_P);
    const bf16* VT = (const bf16*)(p.ws + WS_VT);
    const float qscale = 0.125f * LOG2E;
    const bf16 *Kb0, *Kb1, *Vb; int qrow, nmask = 0;
    if (MODE == 0) { Kb0 = Pm + C_AK + hsel * 128; Kb1 = Kb0 + 64; Vb = VT + (size_t)(b * NVC + hsel * 128) * NKEY;
        qrow = (ctxq ? MLAT + b * CTXL : b * SEQ) + qb * 128 + w * 16 + fr; nmask = ctxq ? 0 : 128; }
    else if (MODE == 1) { Kb0 = Pm + C_SK + hsel * 64; Kb1 = Kb0; Vb = VT + (size_t)(b * NVC + 512 + hsel * 64) * NKEY;
        qrow = (ctxq ? MLAT + b * CTXL : b * SEQ) + qb * 64 + (w & 3) * 16 + fr; }
    else { Kb0 = Pm + C_NK + hsel * 128; Kb1 = Kb0 + 64; Vb = VT + (size_t)(b * NVC + 640 + hsel * 128) * NKEY;
        qrow = (ctxq ? MLAT + b * CTXL : b * SEQ) + qb * 64 + (w & 3) * 16 + fr; }
    int jb0 = 0, rs = 0;
    if (MODE == 1 && !ctxq) { jb0 = qb > 2 ? qb - 2 : 0; const int jb1 = qb < 125 ? qb + 2 : 127; nmask = jb1 - jb0 + 1; }
    if (MODE == 2 && !ctxq) { rs = qb - 4; rs = rs < 0 ? 0 : (rs > 120 ? 120 : rs); nmask = 8; }
    const int ntile = nmask + 4;
    auto tile_rows = [&](int t, int& keyrow0, int& vkey0) {
        if (t >= nmask) { const int j = t - nmask; keyrow0 = MLAT + b * CTXL + j * 64; vkey0 = SEQ + j * 64; }
        else if (MODE == 0) { keyrow0 = b * SEQ + t * 64; vkey0 = t * 64; }
        else if (MODE == 1) { vkey0 = (jb0 + t) * 64; keyrow0 = b * SEQ + vkey0; }
        else { vkey0 = (rs + t) * 64; keyrow0 = b * SEQ + vkey0; }
    };
    bf16x8 qf[NS][2];
    int kslot[NS]; int vrow0 = 0;
    if (MODE == 0) { load_qfrag(Pm, qrow, C_AQ + hsel * 128, g, qscale, qf[0]); load_qfrag(Pm, qrow, C_AQ + hsel * 128 + 64, g, qscale, qf[NS > 1 ? 1 : 0]); kslot[0] = 0; kslot[NS > 1 ? 1 : 0] = 1; }
    else if (MODE == 1) {
#pragma unroll
        for (int st = 0; st < NS; ++st) { load_qfrag(Pm, qrow, C_SQ + (hsel * 4 + (w >> 2) * 2 + st) * 64, g, qscale, qf[st]); kslot[st] = 0; } }
    else { const int hh = w >> 2; load_qfrag(Pm, qrow, C_NQ + (hsel * 2 + hh) * 64, g, qscale, qf[0]); kslot[0] = hh; vrow0 = hh * 64; }
    f32x4 o[NS][DV / 16]; float mrun[NS], lrun[NS];
#pragma unroll
    for (int st = 0; st < NS; ++st) { mrun[st] = 0.f; lrun[st] = 0.f;
#pragma unroll
        for (int dt = 0; dt < DV / 16; ++dt) o[st][dt] = (f32x4){0.f, 0.f, 0.f, 0.f}; }
    u32x4 treg[NBATCH];
    const int lrow = tid >> 3, lch = tid & 7;
    auto issue = [&](int t) {
        int keyrow0, vkey0; tile_rows(t, keyrow0, vkey0);
        if (MODE == 1) {
            treg[0] = *(const u32x4*)(Kb0 + (size_t)(keyrow0 + lrow) * LDP + lch * 8);
            treg[1] = *(const u32x4*)(Vb + (size_t)lrow * NKEY + vkey0 + lch * 8);
        } else {
            treg[0] = *(const u32x4*)(Kb0 + (size_t)(keyrow0 + lrow) * LDP + lch * 8);
            treg[1] = *(const u32x4*)(Kb1 + (size_t)(keyrow0 + lrow) * LDP + lch * 8);
            treg[2] = *(const u32x4*)(Vb + (size_t)lrow * NKEY + vkey0 + lch * 8);
            treg[NBATCH - 1] = *(const u32x4*)(Vb + (size_t)(64 + lrow) * NKEY + vkey0 + lch * 8);
        }
    };
    auto commit = [&](int bufi) {
        LAS unsigned char* bp = lds + bufi * AT_BUF + lrow * AT_PITCH + lch * 16;
        if (MODE == 1) { *(LAS u32x4*)bp = treg[0]; *(LAS u32x4*)(bp + 128 * AT_PITCH) = treg[1]; }
        else { *(LAS u32x4*)bp = treg[0]; *(LAS u32x4*)(bp + 64 * AT_PITCH) = treg[1]; *(LAS u32x4*)(bp + 128 * AT_PITCH) = treg[2]; *(LAS u32x4*)(bp + 192 * AT_PITCH) = treg[NBATCH - 1]; }
    };
    __syncthreads();
    if (MODE == 2 && !ctxq) {
        const float* rpb = p.in[I_RPB] + (size_t)layer * 8 * 465 + (size_t)(hsel * 2) * 465;
        LAS float* tab = (LAS float*)(lds + AT_RPB);
        for (int i = tid; i < 930; i += NT) tab[i] = rpb[i] * LOG2E;
    }
    issue(0); commit(0);
    issue(1);
    __syncthreads();
    const int qpos = qb * 64 + (w & 3) * 16 + fr;
    const int qc = (w & 3) * 16 + fr;
    int cs = qc - 8; cs = cs < 0 ? 0 : (cs > 48 ? 48 : cs);
    bf16x8 pkp[NS][2];
#pragma unroll
    for (int st = 0; st < NS; ++st) { pkp[st][0] = (bf16x8){0, 0, 0, 0, 0, 0, 0, 0}; pkp[st][1] = pkp[st][0]; }
    int bcur = 0, bprev = 0;
    for (int t = 0; t < ntile; ++t) {
        const int bnext = bcur == 2 ? 0 : bcur + 1;
        if (t + 1 < ntile) commit(bnext);
        if (t + 2 < ntile) issue(t + 2);
        const LAS unsigned char* bufK = lds + bcur * AT_BUF; const LAS unsigned char* bufV = lds + bprev * AT_BUF;
        const bool masked = (MODE != 0) && (t < nmask);
        if (MODE == 1) { SwaMask mf{qpos, (jb0 + t) * 64}; attn_step<NS, DV>(bufK, bufV, kslot, vrow0, qf, o, mrun, lrun, pkp, masked, t == 0, mf, lane); }
        else if (MODE == 2) { NaMask mf{qc, cs, ((w >> 2) * 465) + (rs + t - qb + 7) * 31, (const LAS float*)(lds + AT_RPB)}; if (!masked) mf.ro31 = 0;
            attn_step<NS, DV>(bufK, bufV, kslot, vrow0, qf, o, mrun, lrun, pkp, masked, t == 0, mf, lane); }
        else { NoMask mf; attn_step<NS, DV>(bufK, bufV, kslot, vrow0, qf, o, mrun, lrun, pkp, false, t == 0, mf, lane); }
        bprev = bcur; bcur = bnext;
        __syncthreads();
    }
    attn_flush<NS, DV>(lds + bprev * AT_BUF, vrow0, o, pkp, lane);
    float ltot[NS];
#pragma unroll
    for (int st = 0; st < NS; ++st) {
        float l = lrun[st];
        if (MODE == 1) { if (g == 0) l += ex2(p.in[I_SINK][layer * 8 + hsel * 4 + (w >> 2) * 2 + st] * LOG2E - mrun[st]); }
        l += __shfl_xor(l, 16); l += __shfl_xor(l, 32); ltot[st] = 1.0f / l;
    }
    bf16* YS = (bf16*)(p.ws + WS_YS);
    if (MODE == 0) {
        const float lam = ((const float*)(p.ws + WS_LAM))[layer];
        const float lam_init = 0.8f - 0.6f * __expf(-0.3f * (float)layer);
        const float* gs = p.in[I_GSUBLN] + layer * 128;
        f32x4 r[DV / 16]; float ss = 0.f;
#pragma unroll
        for (int dt = 0; dt < DV / 16; ++dt) { r[dt] = o[0][dt] * ltot[0] - o[NS > 1 ? 1 : 0][dt] * (lam * ltot[NS > 1 ? 1 : 0]); ss += (r[dt][0] * r[dt][0] + r[dt][1] * r[dt][1]) + (r[dt][2] * r[dt][2] + r[dt][3] * r[dt][3]); }
        ss += __shfl_xor(ss, 16); ss += __shfl_xor(ss, 32);
        const float rstd = (1.0f - lam_init) / sqrtf(ss * (1.0f / 128.0f) + EPS);
        bf16* orow = YS + (size_t)qrow * 512 + hsel * 128;
#pragma unroll
        for (int dt = 0; dt < DV / 16; ++dt) { const f32x4 gv = *(const f32x4*)(gs + dt * 16 + g * 4);
            u32x2 wv; wv.x = pk2(r[dt][0] * rstd * gv[0], r[dt][1] * rstd * gv[1]); wv.y = pk2(r[dt][2] * rstd * gv[2], r[dt][3] * rstd * gv[3]);
            *(u32x2*)(orow + dt * 16 + g * 4) = wv; }
    } else {
#pragma unroll
        for (int st = 0; st < NS; ++st) {
            bf16* orow = (MODE == 1) ? YS + (size_t)2 * MALL * 512 + (size_t)qrow * 512 + (hsel * 4 + (w >> 2) * 2 + st) * 64
                                     : YS + (size_t)3 * MALL * 512 + (size_t)qrow * 512 + (hsel * 2 + (w >> 2)) * 64;
#pragma unroll
            for (int dt = 0; dt < DV / 16; ++dt) { const f32x4 v = o[st][dt] * ltot[st];
                u32x2 wv; wv.x = pk2(v[0], v[1]); wv.y = pk2(v[2], v[3]); *(u32x2*)(orow + dt * 16 + g * 4) = wv; }
        }
    }
}

constexpr int XT_PITCH = 264;
constexpr int BN_PITCH = 272;
constexpr int SS_XT = 0, SS_B = 256 * XT_PITCH  , SS_C = SS_B + 128 * BN_PITCH  , SS_T0 = SS_C + 128 * BN_PITCH  , SS_T1 = SS_T0 + 4096, SS_TOT = SS_T1 + 4096;
static_assert(SS_TOT + 64 <= LDS_BYTES, "ssd lds");

__device__ __forceinline__ float softplusf_(float x) { return fmaxf(x, 0.f) + log1pf(__expf(-fabsf(x))); }

template <class Put>
__device__ __forceinline__ void conv_pair32(const bf16* Pseq  , int L, int p0, int xch, const float* cw, const float* cb, const Put& put) {
    float w0[5], w1[5];
#pragma unroll
    for (int k = 0; k < 5; ++k) { w0[k] = cw[k * 1024 + xch]; w1[k] = cw[k * 1024 + xch + 1]; }
    const float b0 = cb[xch], b1 = cb[xch + 1];
    float a0 = 0.f, a1 = 0.f, a2 = 0.f, a3 = 0.f, a4 = 0.f, c0 = 0.f, c1 = 0.f, c2 = 0.f, c3 = 0.f, c4 = 0.f;
#pragma unroll
    for (int i = 0; i < 36; ++i) {
        const int pos = p0 + i - 2;
        unsigned raw = 0u;
        if (pos >= 0 && pos < L) raw = *(const unsigned*)(Pseq + (size_t)pos * LDP + xch);
        a0 = a1; a1 = a2; a2 = a3; a3 = a4; a4 = lo16(raw);
        c0 = c1; c1 = c2; c2 = c3; c3 = c4; c4 = hi16(raw);
        if (i >= 4) {
            const float v0 = b0 + w0[0] * a0 + w0[1] * a1 + w0[2] * a2 + w0[3] * a3 + w0[4] * a4;
            const float v1 = b1 + w1[0] * c0 + w1[1] * c1 + w1[2] * c2 + w1[3] * c3 + w1[4] * c4;
            put(i - 4, siluf_(v0), siluf_(v1));
        }
    }
}

struct SsdGeo { int R0, Rseq0, L, pos0; };
__device__ __forceinline__ SsdGeo ssd_geo(int b, int cc) {
    SsdGeo G;
    if (cc < 2) { G.Rseq0 = MLAT + b * CTXL; G.L = CTXL; G.pos0 = cc * 128; }
    else { G.Rseq0 = b * SEQ; G.L = SEQ; G.pos0 = (cc - 2) * 128; }
    G.R0 = G.Rseq0 + G.pos0; return G;
}

__device__ __forceinline__ void ssd_dt_scan(const Params& p, int layer, const bf16* Pm, int R0, int head, int dir, int lane, float (&dt)[2], float (&a)[2], float (&incl)[2], float& total) {
    const float bias = p.in[I_DTBIAS][layer * 16 + dir * 8 + head];
    const float A = -__expf(p.in[I_ALOG][layer * 16 + dir * 8 + head]);
#pragma unroll
    for (int e = 0; e < 2; ++e) { const float raw = bf2f(Pm[(size_t)(R0 + 2 * lane + e) * LDP + C_BDT + dir * 8 + head]); dt[e] = softplusf_(raw + bias); a[e] = dt[e] * A; }
    float s = a[0] + a[1];
#pragma unroll
    for (int off = 1; off < 64; off <<= 1) { const float t = __shfl_up(s, off); if (lane >= off) s += t; }
    const float excl = s - (a[0] + a[1]);
    incl[0] = excl + a[0]; incl[1] = incl[0] + a[1];
    total = __shfl(s, 63);
}

__device__ __forceinline__ void ssd_state_unit(const Params& p, int layer, LAS unsigned char* lds, int b, int cc, int g) {
    const int tid = tid_opaque(), lane = tid & 63, w = __builtin_amdgcn_readfirstlane(tid >> 6), fr = lane & 15, fq = lane >> 4;
    const bf16* Pm = (const bf16*)(p.ws + WS_P);
    const SsdGeo G = ssd_geo(b, cc);
    const float* cw = p.in[I_CONVW] + (size_t)layer * 5 * 1024; const float* cb = p.in[I_CONVB] + layer * 1024;
    __syncthreads();
    for (int it = tid; it < 192 * 4; it += NT) {
        const int pr = it % 192, q = it / 192, c0 = pr * 2;
        const bool isx = c0 < 256;
        const int xch = isx ? g * 256 + c0 : 512 + g * 128 + (c0 - 256);
        LAS unsigned char* dst = isx ? lds + SS_XT + c0 * XT_PITCH : lds + SS_B + (c0 - 256) * BN_PITCH;
        const int pitch = isx ? XT_PITCH : BN_PITCH;
        conv_pair32(Pm + (size_t)G.Rseq0 * LDP + C_BX, G.L, G.pos0 + q * 32, xch, cw, cb, [&](int l, float v0, float v1) {
            const unsigned pk = pk2(v0, v1); const int ll = q * 32 + l;
            *(LAS unsigned short*)(dst + ll * 2) = (unsigned short)(pk & 0xffffu); *(LAS unsigned short*)(dst + pitch + ll * 2) = (unsigned short)(pk >> 16); });
    }
    const int h4 = w >> 1, dir = w & 1, head = g * 4 + h4;
    {
        float dt[2], a[2], incl[2], total;
        ssd_dt_scan(p, layer, Pm, G.R0, head, dir, lane, dt, a, incl, total);
        LAS float* wt = (LAS float*)(lds + SS_T0) + w * 128;
#pragma unroll
        for (int e = 0; e < 2; ++e) wt[2 * lane + e] = dir == 0 ? dt[e] * __expf(total - incl[e]) : dt[e] * __expf(incl[e] - a[e]);
        if (lane == 0) ((float*)(p.ws + WS_DEC))[((b * NCH + cc) * 2 + dir) * 8 + head] = __expf(total);
    }
    __syncthreads();
    float* ST = (float*)(p.ws + WS_ACT) + (size_t)(((b * NCH + cc) * 2 + dir) * 8 + head) * 8192;
#pragma unroll 1
    for (int sh = 0; sh < 2; ++sh) {
        f32x4 acc[4][4];
#pragma unroll
        for (int pt = 0; pt < 4; ++pt)
#pragma unroll
            for (int st = 0; st < 4; ++st) acc[pt][st] = (f32x4){0.f, 0.f, 0.f, 0.f};
#pragma unroll
        for (int ks = 0; ks < 4; ++ks) {
            const LAS float* wt = (const LAS float*)(lds + SS_T0) + w * 128 + ks * 32 + fq * 8;
            const f32x4 wa = *(const LAS f32x4*)wt, wb = *(const LAS f32x4*)(wt + 4);
            bf16x8 bfr[4];
#pragma unroll
            for (int st = 0; st < 4; ++st) bfr[st] = *(const LAS bf16x8*)(lds + SS_B + ((sh * 4 + st) * 16 + fr) * BN_PITCH + (ks * 32 + fq * 8) * 2);
#pragma unroll
            for (int pt = 0; pt < 4; ++pt) {
                const LAS unsigned char* xp = lds + SS_XT + (h4 * 64 + pt * 16 + fr) * XT_PITCH + (ks * 32 + fq * 8) * 2;
                const u32x2 x0 = *(const LAS u32x2*)xp, x1 = *(const LAS u32x2*)(xp + 8);
                u32x4 af; af.x = pk2(lo16(x0.x) * wa[0], hi16(x0.x) * wa[1]); af.y = pk2(lo16(x0.y) * wa[2], hi16(x0.y) * wa[3]);
                af.z = pk2(lo16(x1.x) * wb[0], hi16(x1.x) * wb[1]); af.w = pk2(lo16(x1.y) * wb[2], hi16(x1.y) * wb[3]);
                const bf16x8 afv = __builtin_bit_cast(bf16x8, af);
#pragma unroll
                for (int st = 0; st < 4; ++st) acc[pt][st] = MFMA16(afv, bfr[st], acc[pt][st]);
            }
        }
#pragma unroll
        for (int pt = 0; pt < 4; ++pt)
#pragma unroll
            for (int st = 0; st < 4; ++st)
#pragma unroll
                for (int i = 0; i < 4; ++i) ST[(pt * 16 + fq * 4 + i) * 128 + (sh * 4 + st) * 16 + fr] = acc[pt][st][i];
    }
}

__device__ __forceinline__ void ssd_scan_phase(const Params& p) {
    const int gt = blockIdx.x * NT + tid_opaque(), GT = gridDim.x * NT;
    const float* DEC = (const float*)(p.ws + WS_DEC);
    for (int idx = gt; idx < NB * 2 * 8 * 64 * 64; idx += GT) {
        const int s2 = idx & 63, pp = (idx >> 6) & 63, head = (idx >> 12) & 7, dir = (idx >> 15) & 1, b = idx >> 16;
        f32x2 h = {0.f, 0.f};
        unsigned* HPB = (unsigned*)(p.ws + WS_HPB);
        for (int s0 = 0; s0 < NCH; s0 += 6) {
            f32x2 v[6]; float dc[6]; size_t off[6];
#pragma unroll
            for (int k = 0; k < 6; ++k) { const int s = s0 + k; const int cc = dir == 0 ? s : (s == 0 ? 1 : (s == 1 ? 0 : 67 - s));
                off[k] = ((size_t)(((b * NCH + cc) * 2 + dir) * 8 + head) * 64 + pp) * 128 + s2 * 2;
                v[k] = *(const f32x2*)((const float*)(p.ws + WS_ACT) + off[k]); dc[k] = DEC[((b * NCH + cc) * 2 + dir) * 8 + head]; }
#pragma unroll
            for (int k = 0; k < 6; ++k) { HPB[off[k] >> 1] = pk2(h[0], h[1]); h = h * dc[k] + v[k]; }
        }
    }
}

__device__ __forceinline__ void ssd_out_unit(const Params& p, int layer, LAS unsigned char* lds, int b, int cc, int g, bool do_ssq = true) {
    const int tid = tid_opaque(), lane = tid & 63, w = __builtin_amdgcn_readfirstlane(tid >> 6), fr = lane & 15, fq = lane >> 4;
    const bf16* Pm = (const bf16*)(p.ws + WS_P);
    const SsdGeo G = ssd_geo(b, cc);
    const float* cw = p.in[I_CONVW] + (size_t)layer * 5 * 1024; const float* cb = p.in[I_CONVB] + layer * 1024;
    __syncthreads();
    for (int it = tid; it < 256 * 4; it += NT) {
        const int pr = it & 255, q = it >> 8, c0 = pr * 2;
        if (c0 < 256) {
            LAS unsigned char* dst = lds + SS_XT + c0 * XT_PITCH;
            conv_pair32(Pm + (size_t)G.Rseq0 * LDP + C_BX, G.L, G.pos0 + q * 32, g * 256 + c0, cw, cb, [&](int l, float v0, float v1) {
                const unsigned pk = pk2(v0, v1); const int ll = q * 32 + l;
                *(LAS unsigned short*)(dst + ll * 2) = (unsigned short)(pk & 0xffffu); *(LAS unsigned short*)(dst + XT_PITCH + ll * 2) = (unsigned short)(pk >> 16); });
        } else {
            const int n0 = (c0 - 256) & 127; const bool isC = (c0 - 256) >= 128;
            LAS unsigned char* dst = lds + (isC ? SS_C : SS_B) + n0 * 2;
            conv_pair32(Pm + (size_t)G.Rseq0 * LDP + C_BX, G.L, G.pos0 + q * 32, 512 + (isC ? 256 : 0) + g * 128 + n0, cw, cb, [&](int l, float v0, float v1) {
                *(LAS unsigned*)(dst + (q * 32 + l) * BN_PITCH) = pk2(v0, v1); });
        }
    }
    {
        const int h4 = w >> 1, dir = w & 1;
        float dt[2], a[2], incl[2], total;
        ssd_dt_scan(p, layer, Pm, G.R0, g * 4 + h4, dir, lane, dt, a, incl, total);
        LAS float* t0 = (LAS float*)(lds + SS_T0) + w * 128; LAS float* t1 = (LAS float*)(lds + SS_T1) + w * 128;
#pragma unroll
        for (int e = 0; e < 2; ++e) { t0[2 * lane + e] = dir == 0 ? incl[e] : incl[e] - a[e]; t1[2 * lane + e] = dt[e]; }
        if (lane == 0) ((LAS float*)(lds + SS_TOT))[w] = total;
    }
    __syncthreads();
    const int h4 = w & 3, lh = w >> 2, head = g * 4 + h4;
    const float dsk = p.in[I_DSKIP][layer * 8 + head];
    bf16* Yb = (bf16*)(p.ws + WS_YS) + (size_t)1 * MALL * 512;
    float* SSQ = (float*)(p.ws + WS_SSQ);
#pragma unroll 1
    for (int lp = 0; lp < 2; ++lp) {
    const int lt0 = lh * 4 + lp * 2;
    f32x4 acc[4][2];
#pragma unroll
    for (int pt = 0; pt < 4; ++pt)
#pragma unroll
        for (int lt = 0; lt < 2; ++lt) acc[pt][lt] = (f32x4){0.f, 0.f, 0.f, 0.f};
#pragma unroll 1
    for (int dir = 0; dir < 2; ++dir) {
        const bf16* HP = (const bf16*)(p.ws + WS_HPB) + (size_t)(((b * NCH + cc) * 2 + dir) * 8 + head) * 8192;
        const LAS float* t0 = (const LAS float*)(lds + SS_T0) + (h4 * 2 + dir) * 128;
        const float tot = ((const LAS float*)(lds + SS_TOT))[h4 * 2 + dir];
        bf16x8 hf[4][4];
#pragma unroll
        for (int pt = 0; pt < 4; ++pt)
#pragma unroll
            for (int ks = 0; ks < 4; ++ks) hf[pt][ks] = *(const bf16x8*)(HP + (pt * 16 + fr) * 128 + ks * 32 + fq * 8);
        float el[2];
#pragma unroll
        for (int lt = 0; lt < 2; ++lt) { const float ea = t0[(lt0 + lt) * 16 + fr]; el[lt] = dir == 0 ? __expf(ea) : __expf(tot - ea); }
#pragma unroll
        for (int ks = 0; ks < 4; ++ks) {
            bf16x8 cf[2];
#pragma unroll
            for (int lt = 0; lt < 2; ++lt) { const u32x4 cw4 = *(const LAS u32x4*)(lds + SS_C + ((lt0 + lt) * 16 + fr) * BN_PITCH + (ks * 32 + fq * 8) * 2);
                u32x4 sw; sw.x = pk2(lo16(cw4.x) * el[lt], hi16(cw4.x) * el[lt]); sw.y = pk2(lo16(cw4.y) * el[lt], hi16(cw4.y) * el[lt]);
                sw.z = pk2(lo16(cw4.z) * el[lt], hi16(cw4.z) * el[lt]); sw.w = pk2(lo16(cw4.w) * el[lt], hi16(cw4.w) * el[lt]);
                cf[lt] = __builtin_bit_cast(bf16x8, sw); }
#pragma unroll
            for (int pt = 0; pt < 4; ++pt)
#pragma unroll
                for (int lt = 0; lt < 2; ++lt) acc[pt][lt] = MFMA16(hf[pt][ks], cf[lt], acc[pt][lt]);
        }
    }
#pragma unroll
    for (int lt = 0; lt < 2; ++lt) {
        const int ltg = lt0 + lt;
        f32x4 cbt[8];
#pragma unroll
        for (int st = 0; st < 8; ++st) cbt[st] = (f32x4){0.f, 0.f, 0.f, 0.f};
#pragma unroll
        for (int ks = 0; ks < 4; ++ks) {
            const bf16x8 cfr = *(const LAS bf16x8*)(lds + SS_C + (ltg * 16 + fr) * BN_PITCH + (ks * 32 + fq * 8) * 2);
#pragma unroll
            for (int st = 0; st < 8; ++st) { const bf16x8 bfr = *(const LAS bf16x8*)(lds + SS_B + (st * 16 + fr) * BN_PITCH + (ks * 32 + fq * 8) * 2);
                cbt[st] = MFMA16(bfr, cfr, cbt[st]); }
        }
        __builtin_amdgcn_sched_barrier(0);
#pragma unroll 1
        for (int dir = 0; dir < 2; ++dir) {
            const LAS float* t0 = (const LAS float*)(lds + SS_T0) + (h4 * 2 + dir) * 128;
            const LAS float* t1 = (const LAS float*)(lds + SS_T1) + (h4 * 2 + dir) * 128;
            const int l = ltg * 16 + fr; const float el = t0[l];
            bf16x8 pk[4];
#pragma unroll
            for (int j = 0; j < 4; ++j) {
                float mv[8];
#pragma unroll
                for (int hh = 0; hh < 2; ++hh) { const int st = 2 * j + hh; const int s0 = st * 16 + fq * 4;
                    const f32x4 es = *(const LAS f32x4*)(t0 + s0), ds = *(const LAS f32x4*)(t1 + s0);
#pragma unroll
                    for (int i = 0; i < 4; ++i) { const int s = s0 + i;
                        const bool ok = dir == 0 ? (s <= l) : (s >= l);
                        const float ex = dir == 0 ? el - es[i] : es[i] - el;
                        mv[hh * 4 + i] = ok ? cbt[st][i] * ds[i] * __expf(fminf(ex, 0.f)) : 0.f; } }
                u32x4 wv; wv.x = pk2(mv[0], mv[1]); wv.y = pk2(mv[2], mv[3]); wv.z = pk2(mv[4], mv[5]); wv.w = pk2(mv[6], mv[7]);
                pk[j] = __builtin_bit_cast(bf16x8, wv);
            }
#pragma unroll
            for (int pt = 0; pt < 4; ++pt)
#pragma unroll
                for (int j = 0; j < 4; ++j) {
                    const LAS unsigned char* xp = lds + SS_XT + (h4 * 64 + pt * 16 + fr) * XT_PITCH + (j * 32 + fq * 4) * 2;
                    const u32x2 x0 = *(const LAS u32x2*)xp, x1 = *(const LAS u32x2*)(xp + 32);
                    u32x4 xv; xv.x = x0.x; xv.y = x0.y; xv.z = x1.x; xv.w = x1.y;
                    acc[pt][lt] = MFMA16(__builtin_bit_cast(bf16x8, xv), pk[j], acc[pt][lt]);
                }
        }
    }
    u32x2 zw8[2][4];
#pragma unroll
    for (int lt = 0; lt < 2; ++lt)
#pragma unroll
        for (int pt = 0; pt < 4; ++pt) zw8[lt][pt] = *(const u32x2*)(Pm + (size_t)(G.R0 + (lt0 + lt) * 16 + fr) * LDP + C_BZ + g * 256 + h4 * 64 + pt * 16 + fq * 4);
#pragma unroll
    for (int lt = 0; lt < 2; ++lt) {
        const int l = (lt0 + lt) * 16 + fr, row = G.R0 + l;
        float ss = 0.f;
#pragma unroll
        for (int pt = 0; pt < 4; ++pt) {
            const int ch = h4 * 64 + pt * 16 + fq * 4;
            const u32x2 zw = zw8[lt][pt];
            const float z[4] = {lo16(zw.x), hi16(zw.x), lo16(zw.y), hi16(zw.y)};
            float y[4];
#pragma unroll
            for (int i = 0; i < 4; ++i) { const float xs = bf2f(*(const LAS unsigned short*)(lds + SS_XT + (ch + i) * XT_PITCH + l * 2));
                y[i] = (acc[pt][lt][i] + dsk * xs) * siluf_(z[i]); ss += y[i] * y[i]; }
            u32x2 wv; wv.x = pk2(y[0], y[1]); wv.y = pk2(y[2], y[3]);
            *(u32x2*)(Yb + (size_t)row * 512 + g * 256 + ch) = wv;
        }
        ss += __shfl_xor(ss, 16); ss += __shfl_xor(ss, 32);
        if (fq == 0 && do_ssq) atomicAdd(SSQ + row, ss);
    }
    }
}

#define LDS_WAIT() asm volatile("s_waitcnt lgkmcnt(0)" ::: "memory")

__device__ __forceinline__ void transpose_item(const float* W, int K, int N, int Npad, bf16* WT, const float* kscale, LAS float* scr, int item, int lane) {
    const int nblk = Npad / 64, kb = item / nblk, nb = item % nblk, k0 = kb * 64, n0 = nb * 64;
    const bool nok = (n0 + lane) < N;
#pragma unroll 8
    for (int i = 0; i < 64; ++i) { float v = nok ? W[(size_t)(k0 + i) * N + n0 + lane] : 0.f; if (kscale) v *= kscale[k0 + i]; scr[i * 65 + lane] = v; }
    LDS_WAIT();
    const int c = lane & 7;
#pragma unroll
    for (int j = 0; j < 8; ++j) { const int n = (lane >> 3) + 8 * j; const LAS float* s = scr + (8 * c) * 65 + n;
        u32x4 o; o.x = pk2(s[0 * 65], s[1 * 65]); o.y = pk2(s[2 * 65], s[3 * 65]); o.z = pk2(s[4 * 65], s[5 * 65]); o.w = pk2(s[6 * 65], s[7 * 65]);
        *(u32x4*)(WT + (size_t)(n0 + n) * K + k0 + 8 * c) = o; }
    LDS_WAIT();
}

__device__ __forceinline__ void convert_weights(const Params& p, int layer, LAS unsigned char* lds) {
    const int tid_ = tid_opaque(); const int lane = tid_ & 63, wave = tid_ >> 6;
    const int gw = blockIdx.x * 8 + wave, NGW = gridDim.x * 8;
    LAS float* scr = (LAS float*)(lds + wave * 16640);
    unsigned char* wt = p.ws + WS_WT;
    constexpr int I_IN_ = (D / 64) * (LDP / 64), I_BR1 = (512 / 64) * (D / 64), I_O = (D / 64) * (D / 64), I_1 = (D / 64) * (DFF / 64), I_2 = (DFF / 64) * (D / 64);
    constexpr int NITEMS = I_IN_ + 4 * I_BR1 + I_O + I_1 + I_2;
    for (int it = gw; it < NITEMS; it += NGW) {
        int r = it;
        if (r < I_IN_) { transpose_item(p.in[I_WIN] + (size_t)layer * D * INC, D, INC, LDP, (bf16*)(wt + WT_IN), nullptr, scr, r, lane); continue; } r -= I_IN_;
        if (r < 4 * I_BR1) { const int br = r / I_BR1; transpose_item(p.in[I_WBR] + ((size_t)layer * 4 + br) * 512 * D, 512, D, D, (bf16*)(wt + WT_BR) + (size_t)br * D * 512,
                                                                     br == 1 ? p.in[I_GSSM] + layer * 512 : nullptr, scr, r % I_BR1, lane); continue; } r -= 4 * I_BR1;
        if (r < I_O) { transpose_item(p.in[I_WOUT] + (size_t)layer * D * D, D, D, D, (bf16*)(wt + WT_OUT), nullptr, scr, r, lane); continue; } r -= I_O;
        if (r < I_1) { transpose_item(p.in[I_WFF1] + (size_t)layer * D * DFF, D, DFF, DFF, (bf16*)(wt + WT_F1), nullptr, scr, r, lane); continue; } r -= I_1;
        transpose_item(p.in[I_WFF2] + (size_t)layer * DFF * D, DFF, D, D, (bf16*)(wt + WT_F2), nullptr, scr, r, lane);
    }
}

__device__ __forceinline__ void mod_item(const Params& p, int item, LAS unsigned char* lds) {
    const int tid = tid_opaque(); const int layer = item / 96, j0 = (item % 96) * 128;
    LAS float* sc = (LAS float*)lds;
    LAS float* red = (LAS float*)(lds + 24576);
    __syncthreads();
    for (int i = tid; i < 3 * 2048; i += NT) { const int v = i >> 11, k = i & 2047; const float x = v < 2 ? p.in[I_C][v * D + k] : p.in[I_CCTX][k]; sc[i] = siluf_(x); }
    __syncthreads();
    const int c4 = tid & 31, kq = tid >> 5;
    const float* wm = p.in[I_WMOD] + (size_t)layer * D * 12288 + j0 + c4 * 4;
    f32x4 a0 = {0.f, 0.f, 0.f, 0.f}, a1 = a0, a2 = a0;
#pragma unroll 8
    for (int kk = 0; kk < 128; ++kk) { const int k = kq * 128 + kk; const f32x4 wv = *(const f32x4*)(wm + (size_t)k * 12288);
        a0 = a0 + wv * sc[k]; a1 = a1 + wv * sc[2048 + k]; a2 = a2 + wv * sc[4096 + k]; }
#pragma unroll
    for (int e = 0; e < 4; ++e) { red[(kq * 3 + 0) * 128 + c4 * 4 + e] = a0[e]; red[(kq * 3 + 1) * 128 + c4 * 4 + e] = a1[e]; red[(kq * 3 + 2) * 128 + c4 * 4 + e] = a2[e]; }
    __syncthreads();
    if (tid < 384) { const int v = tid >> 7, c = tid & 127; float s = p.in[I_BMOD][layer * 12288 + j0 + c];
#pragma unroll
        for (int q = 0; q < 16; ++q) s += red[(q * 3 + v) * 128 + c];
        ((float*)(p.ws + WS_MOD))[(size_t)(layer * 3 + v) * 12288 + j0 + c] = s; }
    __syncthreads();
}

template <bool HAS_Y, bool WRITE_H>
__device__ __forceinline__ void row_pass(const float* xrow, const bf16* yrow, const float* yrow32, const float* gpost, const float* mgate, float* xout,
                                         const float* gpre, const float* shift, const float* scale, bf16* hrow, int lane) {
    f32x4 x[8];
#pragma unroll
    for (int j = 0; j < 8; ++j) x[j] = *(const f32x4*)(xrow + (j * 64 + lane) * 4);
    if (HAS_Y) {
        f32x4 y[8], gp[8], mg[8]; float ss = 0.f;
#pragma unroll
        for (int j = 0; j < 8; ++j) { if (yrow32) y[j] = *(const f32x4*)(yrow32 + (j * 64 + lane) * 4); else { const u32x2 yw = *(const u32x2*)(yrow + (j * 64 + lane) * 4); y[j] = (f32x4){lo16(yw.x), hi16(yw.x), lo16(yw.y), hi16(yw.y)}; } }
#pragma unroll
        for (int j = 0; j < 8; ++j) { const int e = (j * 64 + lane) * 4; gp[j] = *(const f32x4*)(gpost + e); mg[j] = *(const f32x4*)(mgate + e); }
#pragma unroll
        for (int j = 0; j < 8; ++j) ss += (y[j][0] * y[j][0] + y[j][1] * y[j][1]) + (y[j][2] * y[j][2] + y[j][3] * y[j][3]);
        const float rstd = 1.0f / sqrtf(wave_sum(ss) * (1.0f / D) + EPS);
#pragma unroll
        for (int j = 0; j < 8; ++j) x[j] = x[j] + mg[j] * (y[j] * rstd * gp[j]);
    }
    if (WRITE_H) {
        f32x4 gq[8], sh[8], scl[8];
#pragma unroll
        for (int j = 0; j < 8; ++j) { const int e = (j * 64 + lane) * 4; gq[j] = *(const f32x4*)(gpre + e); sh[j] = *(const f32x4*)(shift + e); scl[j] = *(const f32x4*)(scale + e); }
        if (HAS_Y) {
#pragma unroll
            for (int j = 0; j < 8; ++j) *(f32x4*)(xout + (j * 64 + lane) * 4) = x[j];
        }
        float ss = 0.f;
#pragma unroll
        for (int j = 0; j < 8; ++j) ss += (x[j][0] * x[j][0] + x[j][1] * x[j][1]) + (x[j][2] * x[j][2] + x[j][3] * x[j][3]);
        const float rstd = 1.0f / sqrtf(wave_sum(ss) * (1.0f / D) + EPS);
#pragma unroll
        for (int j = 0; j < 8; ++j) { const int e = (j * 64 + lane) * 4;
            const f32x4 h = (x[j] * rstd * gq[j]) * (scl[j] + 1.0f) + sh[j];
            u32x2 wv; wv.x = pk2(h[0], h[1]); wv.y = pk2(h[2], h[3]); *(u32x2*)(hrow + e) = wv; }
    } else if (HAS_Y) {
#pragma unroll
        for (int j = 0; j < 8; ++j) *(f32x4*)(xout + (j * 64 + lane) * 4) = x[j];
    }
}

__device__ __forceinline__ void rope_phase(const Params& p) {
    bf16* Pm = (bf16*)(p.ws + WS_P);
    const float* COS = (const float*)(p.ws + WS_COS); const float* SIN = (const float*)(p.ws + WS_SIN);
    const int gt = blockIdx.x * NT + tid_opaque(), GT = gridDim.x * NT;
    constexpr int NITEM = MLAT * 26 * 4;
    for (int idx0 = gt; idx0 < NITEM; idx0 += 4 * GT) {
        u32x4 t1[4], t2[4]; f32x4 c0[4], c1[4], s0[4], s1[4]; bf16* q[4];
#pragma unroll
        for (int k = 0; k < 4; ++k) {
            int idx = idx0 + k * GT; if (idx >= NITEM) idx = idx0;
            const int c = idx & 3, hh = (idx >> 2) % 26, row = (idx >> 2) / 26;
            const int col = hh < 8 ? C_AQ + hh * 64 : (hh < 16 ? C_AK + (hh - 8) * 64 : (hh < 24 ? C_SQ + (hh - 16) * 64 : C_SK + (hh - 24) * 64));
            q[k] = Pm + (size_t)row * LDP + col + c * 8;
            const int pos = row & (SEQ - 1);
            t1[k] = *(const u32x4*)q[k]; t2[k] = *(const u32x4*)(q[k] + 32);
            c0[k] = *(const f32x4*)(COS + pos * 32 + c * 8); c1[k] = *(const f32x4*)(COS + pos * 32 + c * 8 + 4);
            s0[k] = *(const f32x4*)(SIN + pos * 32 + c * 8); s1[k] = *(const f32x4*)(SIN + pos * 32 + c * 8 + 4);
        }
#pragma unroll
        for (int k = 0; k < 4; ++k) {
            if (k > 0 && idx0 + k * GT >= NITEM) continue;
            const float a[8] = {lo16(t1[k].x), hi16(t1[k].x), lo16(t1[k].y), hi16(t1[k].y), lo16(t1[k].z), hi16(t1[k].z), lo16(t1[k].w), hi16(t1[k].w)};
            const float bq[8] = {lo16(t2[k].x), hi16(t2[k].x), lo16(t2[k].y), hi16(t2[k].y), lo16(t2[k].z), hi16(t2[k].z), lo16(t2[k].w), hi16(t2[k].w)};
            const float cs[8] = {c0[k][0], c0[k][1], c0[k][2], c0[k][3], c1[k][0], c1[k][1], c1[k][2], c1[k][3]};
            const float sn[8] = {s0[k][0], s0[k][1], s0[k][2], s0[k][3], s1[k][0], s1[k][1], s1[k][2], s1[k][3]};
            float o1[8], o2[8];
#pragma unroll
            for (int e = 0; e < 8; ++e) { o1[e] = a[e] * cs[e] - bq[e] * sn[e]; o2[e] = bq[e] * cs[e] + a[e] * sn[e]; }
            u32x4 w1, w2; w1.x = pk2(o1[0], o1[1]); w1.y = pk2(o1[2], o1[3]); w1.z = pk2(o1[4], o1[5]); w1.w = pk2(o1[6], o1[7]);
            w2.x = pk2(o2[0], o2[1]); w2.y = pk2(o2[2], o2[3]); w2.z = pk2(o2[4], o2[5]); w2.w = pk2(o2[6], o2[7]);
            *(u32x4*)q[k] = w1; *(u32x4*)(q[k] + 32) = w2;
        }
    }
}

__device__ __forceinline__ void vt_phase(const Params& p, LAS unsigned char* lds) {
    const int tid_ = tid_opaque(); const int lane = tid_ & 63, wave = tid_ >> 6;
    const int gw = blockIdx.x * 8 + wave, NGW = gridDim.x * 8;
    const bf16* Pm = (const bf16*)(p.ws + WS_P); bf16* VT = (bf16*)(p.ws + WS_VT);
    LAS unsigned char* T = lds + wave * 9216;
    for (int it = gw; it < NB * 132 * 18; it += NGW) {
        const int ct = it % 18, kt = (it / 18) % 132, b = it / (18 * 132);
        const int vc0 = ct * 64; const int scol = vc0 < 512 ? C_AV + vc0 : (vc0 < 640 ? C_SV + (vc0 - 512) : C_NV + (vc0 - 640));
        const int krow0 = kt < 128 ? b * SEQ + kt * 64 : MLAT + b * CTXL + (kt - 128) * 64;
        const int rr = lane >> 3, ch = lane & 7;
#pragma unroll
        for (int i = 0; i < 8; ++i) { const int r = i * 8 + rr; *(LAS u32x4*)(T + r * 144 + ch * 16) = *(const u32x4*)(Pm + (size_t)(krow0 + r) * LDP + scol + ch * 8); }
        LDS_WAIT();
#pragma unroll
        for (int i = 0; i < 8; ++i) { const int c = i * 8 + rr;
            unsigned short v[8];
#pragma unroll
            for (int j = 0; j < 8; ++j) v[j] = *(const LAS unsigned short*)(T + (32 * (ch >> 2) + 16 * (j >> 2) + 4 * (ch & 3) + (j & 3)) * 144 + c * 2);
            u32x4 o; o.x = v[0] | ((unsigned)v[1] << 16); o.y = v[2] | ((unsigned)v[3] << 16); o.z = v[4] | ((unsigned)v[5] << 16); o.w = v[6] | ((unsigned)v[7] << 16);
            *(u32x4*)(VT + (size_t)(b * NVC + vc0 + c) * NKEY + kt * 64 + ch * 8) = o; }
        LDS_WAIT();
    }
}

#ifndef MIXREP
#define MIXREP 1
#endif
#ifndef INREP
#define INREP 1
#endif
#ifndef CVREP
#define CVREP 1
#endif
#ifndef P3REP
#define P3REP 1
#endif
#ifndef MGREP
#define MGREP 1
#endif
#ifndef FFREP
#define FFREP 1
#endif
#ifndef SYNCREP
#define SYNCREP 0
#endif
#ifndef ROWREP
#define ROWREP 1
#endif
#ifndef MISCREP
#define MISCREP 1
#endif
#ifndef SOREP
#define SOREP 1
#endif
__global__ void __launch_bounds__(NT, 2) fwd_megakernel(Params p) {
    extern __shared__ __attribute__((aligned(16))) unsigned char lds_raw[];
    LAS unsigned char* lds = (LAS unsigned char*)lds_raw;
    cg::grid_group grid = cg::this_grid();
    { const int t0_ = tid_opaque(); if (t0_ < 16) ((LAS unsigned*)(lds + LDS_BARST))[t0_] = 0u; }
    __syncthreads();
    (void)xcd_barrier_post((unsigned*)(p.ws + WS_BAR), (volatile LAS unsigned*)(lds + LDS_BARST));
#define GSYNC() do { unsigned long long bp_ = (unsigned long long)(p.ws + WS_BAR); asm volatile("" : "+s"(bp_)); XcdBarrier b2_; b2_.bar = (unsigned*)bp_; b2_.x = xb_xcc_id(); b2_.st = (volatile LAS unsigned*)(lds + LDS_BARST); xcd_barrier(b2_); } while (0)
    const int G = gridDim.x, bx = blockIdx.x;
#define ROWIDS() const int tid = tid_opaque(), lane = tid & 63, wave = __builtin_amdgcn_readfirstlane(tid >> 6); const int gw = bx * 8 + wave, NGW = G * 8; (void)lane; (void)gw; (void)NGW
    unsigned char* ws = p.ws;
    float* MOD = (float*)(ws + WS_MOD);
    bf16* ACT = (bf16*)(ws + WS_ACT); bf16* Pm = (bf16*)(ws + WS_P); bf16* FH = (bf16*)(ws + WS_FH); bf16* Y = (bf16*)(ws + WS_Y);
    bf16* YS = (bf16*)(ws + WS_YS); float* CX = (float*)(ws + WS_CX); float* SSQ = (float*)(ws + WS_SSQ);
    const unsigned char* wt = ws + WS_WT;

    for (int rep_ = 0; rep_ < MISCREP; ++rep_) for (int it = bx; it < 192; it += G) mod_item(p, it, lds);
    { const int tid = tid_opaque(); const int gt = bx * NT + tid, GT = G * NT;
    for (int idx = gt; idx < SEQ * 32; idx += GT) { const int pos = idx >> 5, f = idx & 31; const float inv = powf(10000.0f, -(float)(f & 15) / 16.0f);
        const float t = (float)(f < 16 ? (pos >> 6) : (pos & 63)); const float ang = t * inv;
        ((float*)(ws + WS_COS))[idx] = cosf(ang); ((float*)(ws + WS_SIN))[idx] = sinf(ang); }
    if (bx == 0 && tid < 2) { const int l = tid; float s1 = 0.f, s2 = 0.f;
        for (int i = 0; i < 64; ++i) { s1 += p.in[I_LQ1][l * 64 + i] * p.in[I_LK1][l * 64 + i]; s2 += p.in[I_LQ2][l * 64 + i] * p.in[I_LK2][l * 64 + i]; }
        ((float*)(ws + WS_LAM))[l] = expf(s1) - expf(s2) + (0.8f - 0.6f * expf(-0.3f * (float)l)); } }
    __syncthreads();
    for (int rep_ = 0; rep_ < CVREP; ++rep_) convert_weights(p, 0, lds);
    grid.sync();
    for (int rep_ = 0; rep_ < ROWREP; ++rep_) { ROWIDS();
    for (int r = gw; r < MALL; r += NGW) {
        const bool lat = r < MLAT; const int v = lat ? (r >> 13) : 2;
        const float* xr = lat ? p.in[I_X] + (size_t)r * D : p.in[I_CTX] + (size_t)(r - MLAT) * D;
        row_pass<false, true>(xr, nullptr, nullptr, nullptr, nullptr, nullptr, p.in[I_GPREMIX], MOD + (size_t)(v) * 12288, MOD + (size_t)(v) * 12288 + D, ACT + (size_t)r * D, lane);
        if (lane == 0) SSQ[r] = 0.f;
    } }
    GSYNC();

#pragma unroll 1
    for (int layer = 0; layer < NLAYER; ++layer) {
        const bool need_ctx = layer + 1 < NLAYER;
        const int MR = need_ctx ? MALL : MLAT;
        const float* MODL = MOD + (size_t)layer * 3 * 12288;
        { pg8::Gemm g{ACT, (const bf16*)(wt + WT_IN), MALL, LDP, D}; pg8::StaticOrder S; S.init(MALL, LDP, G, bx);
          pg8::EpiBf<0> E{Pm, LDP}; for (int rep_ = 0; rep_ < INREP; ++rep_) pg8::gemm_phase<pg8::EpiBf<0>, pg8::StaticOrder, true, true>(lds, g, S, E); }
        GSYNC();
        for (int rep_ = 0; rep_ < P3REP; ++rep_) {
        for (int u = bx; u < NB * NCH * 2; u += G) { const int g2 = u & 1, cc = (u >> 1) % NCH, b = (u >> 1) / NCH; ssd_state_unit(p, layer, lds, b, cc, g2); }
        __syncthreads();
        vt_phase(p, lds); __syncthreads(); }
        rope_phase(p);
        GSYNC();
        for (int rep_ = 0; rep_ < MISCREP; ++rep_) ssd_scan_phase(p);
        GSYNC();
        for (int rep_ = 0; rep_ < SYNCREP; ++rep_) GSYNC();
        {
            const int n_diff = 512, n_swa = 512, n_na = 1024, n_ssd = NB * (need_ctx ? NCH : 64) * 2;
            const int n_cd = need_ctx ? 16 : 0, n_cs = need_ctx ? 16 : 0, n_cn = need_ctx ? 32 : 0;
            const int total = n_diff + n_swa + n_na + n_ssd + n_cd + n_cs + n_cn;
            for (int u0 = bx; u0 < n_diff; u0 += G) attn_unit<0>(p, layer, lds, (u0 & 7) >> 2, u0 & 3, u0 >> 3, false);
            unsigned* qc = (unsigned*)(ws + WS_BAR + 14336) + layer * 64;
            volatile LAS unsigned* qslot = (volatile LAS unsigned*)(lds + LDS_BARST + 16);
            for (;;) {
                __syncthreads();
                if (tid_opaque() == 0) *qslot = __hip_atomic_fetch_add(qc, 1u, __ATOMIC_RELAXED, __HIP_MEMORY_SCOPE_AGENT);
                __syncthreads();
                int u = (int)*qslot;
                if (u >= total - n_diff) break;
                if (u < n_ssd) { const int g2 = u & 1; int cc = (u >> 1) % (need_ctx ? NCH : 64); const int b = (u >> 1) / (need_ctx ? NCH : 64); if (!need_ctx) cc += 2; ssd_out_unit(p, layer, lds, b, cc, g2); continue; } u -= n_ssd;
                if (u < n_swa) { attn_unit<1>(p, layer, lds, (u & 3) >> 1, u & 1, u >> 2, false); continue; } u -= n_swa;
                if (u < n_na) { attn_unit<2>(p, layer, lds, (u & 7) >> 2, u & 3, u >> 3, false); continue; } u -= n_na;
                if (u < n_cd) { attn_unit<0>(p, layer, lds, (u & 7) >> 2, u & 3, u >> 3, true); continue; } u -= n_cd;
                if (u < n_cs) { attn_unit<1>(p, layer, lds, (u & 3) >> 1, u & 1, u >> 2, true); continue; } u -= n_cs;
                attn_unit<2>(p, layer, lds, (u & 7) >> 2, u & 3, u >> 3, true);
            }
        }
        GSYNC();
        for (int rep_ = 0; rep_ < MGREP; ++rep_) { pg8::MergeOrder S; S.init(MR, D, G, bx);
          pg8::Gemm g{YS, (const bf16*)(wt + WT_BR), MR, D, 512, (size_t)MALL * 512 * 2, (size_t)D * 512 * 2};
          pg8::EpiMerge E{Pm, LDP, C_GATE, ACT, D, SSQ}; pg8::gemm_phase<pg8::EpiMerge, pg8::MergeOrder, true, true>(lds, g, S, E); }
        GSYNC();
        { pg8::Gemm g{ACT, (const bf16*)(wt + WT_OUT), MR, D, D}; pg8::StaticOrder S; S.init(MR, D, G, bx);
          pg8::EpiBf<0> E{Y, D}; for (int rep_ = 0; rep_ < FFREP; ++rep_) pg8::gemm_phase<pg8::EpiBf<0>, pg8::StaticOrder, true, true>(lds, g, S, E); }
        GSYNC();
        for (int rep_ = 0; rep_ < (layer == 0 ? ROWREP : 1); ++rep_) { ROWIDS();
        for (int r = gw; r < MR; r += NGW) {
            const bool lat = r < MLAT; const int v = lat ? (r >> 13) : 2;
            const float* xr = lat ? (layer == 0 ? p.in[I_X] + (size_t)r * D : p.out + (size_t)r * D) : (layer == 0 ? p.in[I_CTX] + (size_t)(r - MLAT) * D : CX + (size_t)(r - MLAT) * D);
            float* xo = lat ? p.out + (size_t)r * D : CX + (size_t)(r - MLAT) * D;
            const float* mv = MODL + (size_t)v * 12288;
            if (!lat) { float* yc = (float*)(ws + WS_YC) + (size_t)(r - MLAT) * D;
#pragma unroll
                for (int j = 0; j < 8; ++j) *(f32x4*)(yc + (j * 64 + lane) * 4) = (f32x4){0.f, 0.f, 0.f, 0.f}; }
            row_pass<true, true>(xr, Y + (size_t)r * D, nullptr, p.in[I_GPOSTMIX] + layer * D, mv + 2 * D, xo, p.in[I_GPREMLP] + layer * D, mv + 3 * D, mv + 4 * D, ACT + (size_t)r * D, lane);
        } }
        GSYNC();
        { pg8::Gemm g{ACT, (const bf16*)(wt + WT_F1), MR, DFF, D}; pg8::StaticOrder S; S.init(MR, DFF, G, bx);
          pg8::EpiBf<2> E{FH, DFF}; for (int rep_ = 0; rep_ < FFREP; ++rep_) pg8::gemm_phase<pg8::EpiBf<2>, pg8::StaticOrder, true, true>(lds, g, S, E); }
        GSYNC();
        { pg8::Gemm g{FH, (const bf16*)(wt + WT_F2), MLAT, D, DFF}; pg8::StaticOrder S; S.init(MLAT, D, G, bx);
          pg8::EpiBf<0> E{Y, D}; for (int rep_ = 0; rep_ < FFREP; ++rep_) pg8::gemm_phase<pg8::EpiBf<0>, pg8::StaticOrder, true, true>(lds, g, S, E); }
        if (need_ctx) { pg8::Gemm g{FH + (size_t)MLAT * DFF, (const bf16*)(wt + WT_F2), MCTX, D, 2048, (size_t)2048 * 2, (size_t)2048 * 2, DFF}; pg8::SplitOrder S; S.init(MCTX, D, G, bx);
          pg8::EpiAtomicF32 E{(float*)(ws + WS_YC), D}; pg8::gemm_phase<pg8::EpiAtomicF32, pg8::SplitOrder, true, true>(lds, g, S, E); }
        GSYNC();
        if (need_ctx) {
            const float* MODN = MOD + (size_t)(layer + 1) * 3 * 12288;
            { ROWIDS();
            for (int r = gw; r < MALL; r += NGW) {
                const bool lat = r < MLAT; const int v = lat ? (r >> 13) : 2;
                float* xo = lat ? p.out + (size_t)r * D : CX + (size_t)(r - MLAT) * D;
                row_pass<true, true>(xo, Y + (size_t)r * D, lat ? nullptr : (const float*)(ws + WS_YC) + (size_t)(r - MLAT) * D, p.in[I_GPOSTMLP] + layer * D, MODL + (size_t)v * 12288 + 5 * D, xo,
                                     p.in[I_GPREMIX] + (layer + 1) * D, MODN + (size_t)v * 12288, MODN + (size_t)v * 12288 + D, ACT + (size_t)r * D, lane);
                if (lane == 0) SSQ[r] = 0.f;
            } }
            __syncthreads();
            for (int rep_ = 0; rep_ < CVREP; ++rep_) convert_weights(p, layer + 1, lds);
            GSYNC();
        } else {
            ROWIDS();
            for (int r = gw; r < MLAT; r += NGW) {
                float* xo = p.out + (size_t)r * D;
                row_pass<true, false>(xo, Y + (size_t)r * D, nullptr, p.in[I_GPOSTMLP] + layer * D, MODL + (size_t)(r >> 13) * 12288 + 5 * D, xo, nullptr, nullptr, nullptr, nullptr, lane);
            }
        }
    }
}

extern "C" void kernel_launch(void* const* d_in, const int* in_sizes, int n_in, void* d_out, int out_size, void* d_ws, size_t ws_size, hipStream_t stream) {
    static int grid = 0;
    if (grid == 0) {
        if (n_in != 28 || out_size != MLAT * D || ws_size < WS_END) { fprintf(stderr, "kernel_launch: unexpected problem (n_in %d out %d ws %zu)\n", n_in, out_size, ws_size); grid = -1; return; }
        int dev = 0, cus = 0, per_cu = 0;
        (void)hipGetDevice(&dev); (void)hipDeviceGetAttribute(&cus, hipDeviceAttributeMultiprocessorCount, dev);
        (void)hipFuncSetAttribute((const void*)fwd_megakernel, hipFuncAttributeMaxDynamicSharedMemorySize, LDS_BYTES);
        (void)hipOccupancyMaxActiveBlocksPerMultiprocessor(&per_cu, (const void*)fwd_megakernel, NT, LDS_BYTES);
        (void)hipGetLastError();
        if (per_cu < 1) per_cu = 1;
        grid = cus * per_cu;
        fprintf(stderr, "kernel_launch: cus %d per_cu %d grid %d ws %zu\n", cus, per_cu, grid, ws_size);
    }
    if (grid < 0) return;
    (void)hipMemsetAsync((unsigned char*)d_ws + WS_BAR, 0, 16384, stream);
    Params p{};
    for (int i = 0; i < 28; ++i) p.in[i] = (const float*)d_in[i];
    p.out = (float*)d_out; p.ws = (unsigned char*)d_ws;
    void* args[] = {&p};
    hipError_t e = hipLaunchCooperativeKernel((const void*)fwd_megakernel, dim3(grid), dim3(NT), args, LDS_BYTES, stream);
    if (e != hipSuccess) fprintf(stderr, "cooperative launch failed: %s (grid %d)\n", hipGetErrorString(e), grid);
}
```

```cpp
#include <hip/hip_runtime.h>
#include <hip/hip_cooperative_groups.h>
#include <cstdio>
#include <cstdint>
namespace cg = cooperative_groups;

constexpr int D = 2048, NB = 2, SEQ = 8192, CTXL = 256, DFF = 8192, NLAYER = 2;
constexpr int MLAT = NB * SEQ, MCTX = NB * CTXL, MALL = MLAT + MCTX;
constexpr int INC = 13584, LDP = 13824;
constexpr int C_AQ = 0, C_AK = 512, C_AV = 1024, C_BZ = 1536, C_BX = 2048, C_BDT = 3072, C_SQ = 3088, C_SK = 3600, C_SV = 3728,
              C_NQ = 3856, C_NK = 4368, C_NV = 4880, C_GATE = 5392;
constexpr int NKEY = SEQ + CTXL;
constexpr int NVC = 1152;
constexpr int NCH = 66;
constexpr float EPS = 1e-6f;
constexpr float LOG2E = 1.4426950408889634f;

constexpr size_t MiB = 1u << 20;
constexpr size_t WS_MOD = 0;
constexpr size_t WS_LAM = 512 * 1024;
constexpr size_t WS_DEC = 576 * 1024;
constexpr size_t WS_SSQ = 640 * 1024;
constexpr size_t WS_BAR = 768 * 1024;
constexpr size_t WS_COS = 1 * MiB, WS_SIN = 2 * MiB;
constexpr size_t WS_CX = 4 * MiB;
constexpr size_t WS_WT = 8 * MiB;
constexpr size_t WT_IN = 0, WT_BR = (size_t)LDP * D * 2, WT_OUT = WT_BR + (size_t)4 * D * 512 * 2, WT_F1 = WT_OUT + (size_t)D * D * 2, WT_F2 = WT_F1 + (size_t)DFF * D * 2;
constexpr size_t WS_ACT = 142 * MiB;
constexpr size_t WS_P = 208 * MiB;
constexpr size_t WS_FH = WS_P;
constexpr size_t WS_Y = WS_P + 264 * MiB;
constexpr size_t WS_YS = 654 * MiB;
constexpr size_t WS_VT = 720 * MiB;
constexpr size_t WS_HPB = 758 * MiB;
constexpr size_t WS_YC = 791 * MiB;
constexpr size_t WS_END = 795 * MiB;
static_assert(WT_F2 + (size_t)D * DFF * 2 == 134 * MiB, "weights");
static_assert((size_t)MALL * D * 2 == 66 * MiB, "act");
static_assert(WS_P + (size_t)MALL * LDP * 2 <= WS_YS, "P");
static_assert(WS_Y + (size_t)MALL * D * 4 <= WS_YS, "Y");
static_assert(WS_VT + (size_t)NB * NVC * NKEY * 2 <= WS_HPB, "VT");
static_assert((size_t)NB * NCH * 2 * 8 * 64 * 128 * 4 == 66 * MiB, "states alias ACT exactly");

constexpr int LDS_BYTES = 147456;
constexpr int LDS_BARST = LDS_BYTES - 64;
constexpr int NT = 512;

#define LAS __attribute__((address_space(3)))
#define GAS __attribute__((address_space(1)))
typedef unsigned short bf16;
typedef short bf16x8 __attribute__((ext_vector_type(8)));
typedef short bf16x4 __attribute__((ext_vector_type(4)));
typedef float f32x4 __attribute__((ext_vector_type(4)));
typedef float f32x2 __attribute__((ext_vector_type(2)));
typedef unsigned u32x4 __attribute__((ext_vector_type(4)));
typedef unsigned u32x2 __attribute__((ext_vector_type(2)));

__device__ __forceinline__ float bf2f(unsigned v) { return __uint_as_float(v << 16); }
__device__ __forceinline__ unsigned f2bf(float f) { unsigned u = __float_as_uint(f); return (u + 0x7fffu + ((u >> 16) & 1u)) >> 16; }
__device__ __forceinline__ unsigned pk2(float lo, float hi) { unsigned r; asm volatile("v_cvt_pk_bf16_f32 %0, %1, %2" : "=v"(r) : "v"(lo), "v"(hi)); return r; }
__device__ __forceinline__ float lo16(unsigned w) { return __uint_as_float(w << 16); }
__device__ __forceinline__ float hi16(unsigned w) { return __uint_as_float(w & 0xffff0000u); }
__device__ __forceinline__ float ex2(float x) { return __builtin_amdgcn_exp2f(x); }
__device__ __forceinline__ float sigmoidf_(float x) { return 1.0f / (1.0f + __expf(-x)); }
__device__ __forceinline__ float siluf_(float x) { return x / (1.0f + __expf(-x)); }
__device__ __forceinline__ float wave_sum(float v) {
#pragma unroll
    for (int o = 1; o < 64; o <<= 1) v += __shfl_xor(v, o);
    return v;
}

__device__ __forceinline__ int tid_opaque() { int t = threadIdx.x; asm volatile("" : "+v"(t)); return t; }
__device__ __forceinline__ int sgpr_opaque(int v) { asm volatile("" : "+s"(v)); return v; }

struct Params {
    const float* in[28];
    float* out;
    unsigned char* ws;
};
enum { I_X = 0, I_C, I_CTX, I_CCTX, I_WMOD, I_BMOD, I_GPREMIX, I_GPOSTMIX, I_GPREMLP, I_GPOSTMLP, I_WIN, I_LQ1, I_LK1, I_LQ2, I_LK2, I_GSUBLN,
       I_CONVW, I_CONVB, I_DTBIAS, I_ALOG, I_DSKIP, I_GSSM, I_SINK, I_RPB, I_WBR, I_WOUT, I_WFF1, I_WFF2 };
#define XB_TMO      128
#define XB_XCNT(j)  (256  + 64 * (j))
#define XB_XSUB(j)  (1280 + 64 * (j))
#define XB_XGEN(j)  (2304 + 64 * (j))
#define XB_TOP      3328
#define XB_TOPGEN   3392
#define XCD_BAR_WORDS 3456
#define XB_SPIN_CAP (1u << 18)

__device__ __forceinline__ unsigned xb_ld(unsigned* p)              { return __hip_atomic_load(p, __ATOMIC_RELAXED, __HIP_MEMORY_SCOPE_AGENT); }
__device__ __forceinline__ unsigned xb_add(unsigned* p, unsigned v) { return __hip_atomic_fetch_add(p, v, __ATOMIC_RELAXED, __HIP_MEMORY_SCOPE_AGENT); }
__device__ __forceinline__ unsigned xb_xcc_id() { return (unsigned)__builtin_amdgcn_s_getreg((3 << 11) | 20) & 0xFu; }
#define XB_SPIN(cond, bar) do { unsigned _sp = 0; while (cond) { __builtin_amdgcn_s_sleep(1); \
    if ((++_sp & 255u) == 0u) { if (xb_ld(&(bar)[XB_TMO])) break; if (_sp > XB_SPIN_CAP) { atomicAdd(&(bar)[XB_TMO], 1u); break; } } } } while (0)

struct XcdBarrier {
    unsigned* bar; unsigned x;
    volatile LAS unsigned* st;
};

__device__ __forceinline__ XcdBarrier xcd_barrier_post(unsigned* bar, volatile LAS unsigned* st) {
    XcdBarrier b; b.bar = bar; b.x = xb_xcc_id(); b.st = st;
    if (threadIdx.x == 0) (void)xb_add(&bar[XB_XCNT(b.x)], 1u);
    return b;
}
__device__ __forceinline__ void xcd_barrier_complete(unsigned* bar, unsigned x, unsigned& nloc, unsigned& nx) {
    const unsigned G = gridDim.x * gridDim.y * gridDim.z;
    unsigned sum, cnt, mine, sp = 0u;
    for (;;) {
        sum = 0u; cnt = 0u; mine = 0u;
#pragma unroll
        for (unsigned j = 0; j < 16; ++j) { const unsigned c = xb_ld(&bar[XB_XCNT(j)]); sum += c; cnt += (c > 0u) ? 1u : 0u; mine = (j == x) ? c : mine; }
        if (sum == G) break;
        __builtin_amdgcn_s_sleep(1);
        if ((++sp & 255u) == 0u) { if (xb_ld(&bar[XB_TMO])) break; if (sp > XB_SPIN_CAP) { atomicAdd(&bar[XB_TMO], 1u); break; } }
    }
    nloc = mine > 0u ? mine : 1u; nx = cnt > 0u ? cnt : 1u;
}

__device__ __forceinline__ void xcd_barrier(const XcdBarrier& b) {
    asm volatile("s_waitcnt vmcnt(0)" ::: "memory");
    __syncthreads();
    if (threadIdx.x == 0) {
        unsigned* bar = b.bar;
        __builtin_amdgcn_s_waitcnt(0);
        unsigned nloc = b.st[0], nx = b.st[1];
        if (nloc == 0u) { xcd_barrier_complete(bar, b.x, nloc, nx); b.st[0] = nloc; b.st[1] = nx; }
        const unsigned old = xb_add(&bar[XB_XSUB(b.x)], 1u);
        const unsigned gen = old / nloc;
        if (old + 1u == (gen + 1u) * nloc) {
            __builtin_amdgcn_fence(__ATOMIC_RELEASE, "agent");
            asm volatile("s_waitcnt vmcnt(0)" ::: "memory");
            const unsigned og = xb_add(&bar[XB_TOP], 1u);
            const unsigned tg = og / nx;
            if (og + 1u == (tg + 1u) * nx) xb_add(&bar[XB_TOPGEN], 1u);
            else XB_SPIN(xb_ld(&bar[XB_TOPGEN]) == tg, bar);
            __builtin_amdgcn_fence(__ATOMIC_ACQUIRE, "agent");
            xb_add(&bar[XB_XGEN(b.x)], 1u);
            asm volatile("s_waitcnt vmcnt(0)" ::: "memory");
        } else {
            XB_SPIN(xb_ld(&bar[XB_XGEN(b.x)]) == gen, bar);
            __builtin_amdgcn_fence(__ATOMIC_ACQUIRE, "agent");
            asm volatile("s_waitcnt vmcnt(0)" ::: "memory");
        }
    }
    __syncthreads();
}
namespace pg8 {
#define PG8_LAS __attribute__((address_space(3)))
typedef unsigned short bf16_t;
typedef short bf16x8 __attribute__((ext_vector_type(8)));
typedef float f32x4 __attribute__((ext_vector_type(4)));
typedef unsigned u32x4 __attribute__((ext_vector_type(4)));
constexpr int BM = 256, BK = 64, HALF = 128, HTB = HALF * BK * 2  , STAGE_BYTES = 8 * HTB, NXCD = 8, WGM = 8;

__host__ __device__ __forceinline__ int lds_byte(int r, int c) { const int st = (r >> 4) * 2 + (c >> 5), rr = r & 15, cc = c & 31, ob = rr * 64 + cc * 2; return st * 1024 + (ob ^ (((ob >> 9) & 1) << 5)); }
__host__ __device__ __forceinline__ void stage_rc(int b, int& R, int& C) { const int st = b / 1024, sb = b % 1024, swz = sb ^ (((sb >> 9) & 1) << 5); R = (st >> 1) * 16 + swz / 64; C = (st & 1) * 32 + (swz % 64) / 2; }
__host__ __device__ __forceinline__ int perm32(int rho) { const int n = rho >> 4, i = rho & 15; return 8 * (i >> 2) + 4 * n + (i & 3); }

struct Unit { int pm, pn, z; };
struct Gemm { const bf16_t* A; const bf16_t* Bt; int M, N, K; size_t zA, zB; int ld; };

struct StaticOrder {
    int nM, nN, nwg, G, c;
    __host__ __device__ void init(int M, int N, int G_, int c_) { nM = M / BM; nN = N / BM; nwg = nM * nN; G = G_; c = c_; }
    __host__ __device__ bool next(int i, Unit& u) const {
        const long L = (long)i * G + c; if (L >= nwg) return false;
        int wgid = (int)L; { const int q = nwg / NXCD, r = nwg % NXCD, xcd = wgid % NXCD, off = wgid / NXCD; wgid = (xcd < r ? xcd * (q + 1) : r * (q + 1) + (xcd - r) * q) + off; }
        const int nig = WGM * nN, gid = wgid / nig, fm = gid * WGM, gsz = (nM - fm) < WGM ? (nM - fm) : WGM;
        u.pm = fm + ((wgid % nig) % gsz); u.pn = (wgid % nig) / gsz; u.z = 0; return true;
    }
    __device__ __forceinline__ void a_ready(const Unit&) const {}
    __device__ __forceinline__ void done(const Unit&) const {}
};


struct MergeOrder {
    StaticOrder base;
    __host__ __device__ void init(int M, int N, int G_, int c_) { base.init(M, N, G_, c_); }
    __host__ __device__ bool next(int i, Unit& u) const { if (!base.next(i >> 2, u)) return false; u.z = i & 3; return true; }
    __device__ __forceinline__ void a_ready(const Unit&) const {}
    __device__ __forceinline__ void done(const Unit&) const {}
};

struct SplitOrder {
    int nN, nunits, G, c;
    __host__ __device__ void init(int M, int N, int G_, int c_) { nN = N / BM; nunits = (M / BM) * nN * 4; G = G_; c = c_; }
    __host__ __device__ bool next(int i, Unit& u) const { const int L = i * G + c; if (L >= nunits) return false; const int t = L >> 2; u.z = L & 3; u.pm = t / nN; u.pn = t % nN; return true; }
    __device__ __forceinline__ void a_ready(const Unit&) const {}
    __device__ __forceinline__ void done(const Unit&) const {}
};

template <class E, class = void> struct EpiChain { static constexpr bool value = false; };
template <class E> struct EpiChain<E, decltype((void)E::CHAIN)> { static constexpr bool value = E::CHAIN; };

__device__ __forceinline__ unsigned cvt_pk_bf16(float lo, float hi) { unsigned r; asm volatile("v_cvt_pk_bf16_f32 %0, %1, %2" : "=v"(r) : "v"(lo), "v"(hi)); return r; }

template <int ACT  > struct EpiBf {
    static constexpr bool PERM = true, AFTER_DRAIN = false;
    bf16_t* O; int ldc;
    __device__ __forceinline__ void operator()(const f32x4 (&acc)[2][2][4][2], const Unit& u, int wr, int wc, int fr, int fq) const {
        const int row0 = u.pm * BM + wr * 64 + fr, col0 = u.pn * BM + wc * 32 + 8 * fq;
#pragma unroll
        for (int ai = 0; ai < 2; ++ai)
#pragma unroll
            for (int m = 0; m < 4; ++m) { bf16_t* rowp = O + (size_t)(row0 + ai * HALF + m * 16) * ldc + col0;
#pragma unroll
                for (int bj = 0; bj < 2; ++bj) { f32x4 v0 = acc[ai][bj][m][0], v1 = acc[ai][bj][m][1];
                    if (ACT == 2) {
#pragma unroll
                        for (int e = 0; e < 4; ++e) { float a = fmaxf(v0[e], 0.f), b = fmaxf(v1[e], 0.f); v0[e] = a * a; v1[e] = b * b; } }
                    u32x4 w; w.x = cvt_pk_bf16(v0[0], v0[1]); w.y = cvt_pk_bf16(v0[2], v0[3]); w.z = cvt_pk_bf16(v1[0], v1[1]); w.w = cvt_pk_bf16(v1[2], v1[3]);
                    *(u32x4*)(rowp + bj * HALF) = w; } }
    }
};
struct EpiF32 {
    static constexpr bool PERM = true, AFTER_DRAIN = false;
    float* O; int ldc;
    __device__ __forceinline__ void operator()(const f32x4 (&acc)[2][2][4][2], const Unit& u, int wr, int wc, int fr, int fq) const {
        const int row0 = u.pm * BM + wr * 64 + fr, col0 = u.pn * BM + wc * 32 + 8 * fq;
#pragma unroll
        for (int ai = 0; ai < 2; ++ai)
#pragma unroll
            for (int m = 0; m < 4; ++m) { float* rowp = O + (size_t)(row0 + ai * HALF + m * 16) * ldc + col0;
#pragma unroll
                for (int bj = 0; bj < 2; ++bj) { *(f32x4*)(rowp + bj * HALF) = acc[ai][bj][m][0]; *(f32x4*)(rowp + bj * HALF + 4) = acc[ai][bj][m][1]; } }
    }
};
struct EpiMerge {
    static constexpr bool PERM = true, AFTER_DRAIN = false, CHAIN = true;
    const bf16_t* P; int ldp; int gcol; bf16_t* O; int ldc; const float* ssq;
    __device__ __forceinline__ void chain(f32x4 (&acc)[2][2][4][2], const Unit& u, int wr, int wc, int fr, int fq) const {
        const int row0 = u.pm * BM + wr * 64 + fr, col0 = u.pn * BM + wc * 32 + 8 * fq; const int z = u.z;
        constexpr float L2E = 1.4426950408889634f;
#pragma unroll
        for (int aim = 0; aim < 4; ++aim) { const int ai = aim >> 1, m0 = (aim & 1) * 2;
            u32x4 gz[4][2], gn[4][2]; float sq[4];
#pragma unroll
            for (int m = m0; m < m0 + 2; ++m) { const int row = row0 + ai * HALF + m * 16; const bf16_t* gp = P + (size_t)row * ldp + gcol + z * 2048 + col0;
                sq[m] = z < 2 ? ssq[row] : 512.0f;
#pragma unroll
                for (int bj = 0; bj < 2; ++bj) { gz[m][bj] = *(const u32x4*)(gp + bj * HALF); gn[m][bj] = z < 3 ? *(const u32x4*)(gp + 2048 + bj * HALF) : (u32x4){0u, 0u, 0u, 0u}; } }
#pragma unroll
            for (int m = m0; m < m0 + 2; ++m) { const int row = row0 + ai * HALF + m * 16; bf16_t* rowp = O + (size_t)row * ldc + col0;
                float rsf = 1.f; if (z < 2) { const float rs = 1.0f / sqrtf(sq[m] * (1.0f / 512.0f) + 1e-6f); rsf = z == 1 ? rs : 1.0f / rs; }
#pragma unroll
                for (int bj = 0; bj < 2; ++bj) {
                    const u32x4 gw = gz[m][bj];
                    const float g[8] = { __uint_as_float(gw.x << 16), __uint_as_float(gw.x & 0xffff0000u), __uint_as_float(gw.y << 16), __uint_as_float(gw.y & 0xffff0000u),
                                         __uint_as_float(gw.z << 16), __uint_as_float(gw.z & 0xffff0000u), __uint_as_float(gw.w << 16), __uint_as_float(gw.w & 0xffff0000u) };
                    float f[8];
#pragma unroll
                    for (int e = 0; e < 8; ++e) f[e] = __builtin_amdgcn_rcpf(1.0f + __builtin_amdgcn_exp2f(-L2E * g[e])) * rsf;
                    if (z < 3) {
                        const u32x4 nw = gn[m][bj];
                        const float gnx[8] = { __uint_as_float(nw.x << 16), __uint_as_float(nw.x & 0xffff0000u), __uint_as_float(nw.y << 16), __uint_as_float(nw.y & 0xffff0000u),
                                               __uint_as_float(nw.z << 16), __uint_as_float(nw.z & 0xffff0000u), __uint_as_float(nw.w << 16), __uint_as_float(nw.w & 0xffff0000u) };
#pragma unroll
                        for (int e = 0; e < 8; ++e) f[e] *= (1.0f + __builtin_amdgcn_exp2f(-L2E * gnx[e]));
#pragma unroll
                        for (int e = 0; e < 4; ++e) { acc[ai][bj][m][0][e] *= f[e]; acc[ai][bj][m][1][e] *= f[4 + e]; }
                    } else {
                        const f32x4 v0 = acc[ai][bj][m][0], v1 = acc[ai][bj][m][1];
                        u32x4 w; w.x = cvt_pk_bf16(v0[0] * f[0], v0[1] * f[1]); w.y = cvt_pk_bf16(v0[2] * f[2], v0[3] * f[3]); w.z = cvt_pk_bf16(v1[0] * f[4], v1[1] * f[5]); w.w = cvt_pk_bf16(v1[2] * f[6], v1[3] * f[7]);
                        *(u32x4*)(rowp + bj * HALF) = w;
                    }
                } }
        }
    }
    __device__ __forceinline__ void operator()(const f32x4 (&)[2][2][4][2], const Unit&, int, int, int, int) const {}
};
struct EpiAtomicF32 {
    static constexpr bool PERM = true, AFTER_DRAIN = false;
    float* O; int ldc;
    __device__ __forceinline__ void operator()(const f32x4 (&acc)[2][2][4][2], const Unit& u, int wr, int wc, int fr, int fq) const {
        const int row0 = u.pm * BM + wr * 64 + fr, col0 = u.pn * BM + wc * 32 + 8 * fq;
#pragma unroll
        for (int ai = 0; ai < 2; ++ai)
#pragma unroll
            for (int m = 0; m < 4; ++m) { float* rowp = O + (size_t)(row0 + ai * HALF + m * 16) * ldc + col0;
#pragma unroll
                for (int bj = 0; bj < 2; ++bj)
#pragma unroll
                    for (int e2 = 0; e2 < 4; ++e2) { unsafeAtomicAdd(rowp + bj * HALF + e2, acc[ai][bj][m][0][e2]); unsafeAtomicAdd(rowp + bj * HALF + 4 + e2, acc[ai][bj][m][1][e2]); } }
    }
};
template <class Epi, class Sched, bool ALIGN_EPI = false, bool SP2 = false>
__device__ __forceinline__ void gemm_phase(PG8_LAS unsigned char* lds, const Gemm g, const Sched& S, const Epi& E) {
    const int tid = tid_opaque(), wid = __builtin_amdgcn_readfirstlane(tid >> 6), lane = tid & 63, wr = wid >> 2, wc = wid & 3, fr = lane & 15, fq = lane >> 4;
    const int K = g.K, nt = K / BK, LD = g.ld ? g.ld : g.K;
    unsigned voffA[2], voffB[2];
#pragma unroll
    for (int i = 0; i < 2; ++i) { int R, C; stage_rc(tid * 16 + i * 8192, R, C); const int Rb = Epi::PERM ? ((R & ~31) + perm32(R & 31)) : R;
        voffA[i] = (unsigned)(R * LD + C) * 2u; voffB[i] = (unsigned)(Rb * LD + C) * 2u; }
    const size_t kstep = (size_t)(BK * 2);
    const size_t hstep = (size_t)HALF * LD * 2;
    const size_t tstep = 2 * hstep;
    const unsigned ldsw = (unsigned)wid * 1024u;
    const int aoff = lds_byte(wr * 64 + fr, fq * 8), boff = lds_byte(wc * 32 + fr, fq * 8);
#define PG8_SA(b, h) (((b) * 2 + (h)) * HTB)
#define PG8_SB(b, h) ((4 + (b) * 2 + (h)) * HTB)
#define PG8_STAGE(bufoff, gbase, voff) do { _Pragma("unroll") for (int _i = 0; _i < 2; ++_i) \
        __builtin_amdgcn_global_load_lds((const unsigned*)((const char*)(gbase) + (voff)[_i]), (PG8_LAS unsigned*)(lds + (bufoff) + ldsw + _i * 8192), 16, 0, 0); } while (0)
#define PG8_LDA(dst, b, h) do { _Pragma("unroll") for (int m = 0; m < 4; ++m) _Pragma("unroll") for (int k = 0; k < 2; ++k) dst[m][k] = *(const PG8_LAS bf16x8*)(lds + PG8_SA(b, h) + aoff + m * 2048 + k * 1024); } while (0)
#define PG8_LDB(dst, b, h) do { _Pragma("unroll") for (int n = 0; n < 2; ++n) _Pragma("unroll") for (int k = 0; k < 2; ++k) dst[n][k] = *(const PG8_LAS bf16x8*)(lds + PG8_SB(b, h) + boff + n * 2048 + k * 1024); } while (0)
#define PG8_MMA(ai, bj, At, Bt) do { __builtin_amdgcn_s_setprio(1); _Pragma("unroll") for (int m = 0; m < 4; ++m) _Pragma("unroll") for (int n = 0; n < 2; ++n) _Pragma("unroll") for (int k = 0; k < 2; ++k) \
        acc[ai][bj][m][n] = __builtin_amdgcn_mfma_f32_16x16x32_bf16(Bt[n][k], At[m][k], acc[ai][bj][m][n], 0, 0, 0); __builtin_amdgcn_s_setprio(0); } while (0)
#define PG8_WAIT_V(n) asm volatile("s_waitcnt vmcnt(" #n ")" ::: "memory")
#define PG8_WAIT_L(n) asm volatile("s_waitcnt lgkmcnt(" #n ")" ::: "memory")
#define PG8_BAR __builtin_amdgcn_s_barrier()
#define PG8_SCHED __builtin_amdgcn_sched_barrier(0)
    Unit cur, nxt; int ui = 0;
    if (!S.next(0, cur)) return;
    f32x4 acc[2][2][4][2];
#pragma unroll
    for (int a = 0; a < 2; ++a)
#pragma unroll
        for (int b = 0; b < 2; ++b)
#pragma unroll
            for (int m = 0; m < 4; ++m)
#pragma unroll
                for (int n = 0; n < 2; ++n) acc[a][b][m][n] = (f32x4){0.f, 0.f, 0.f, 0.f};
    bf16x8 At[4][2], B0[2][2], B1[2][2];
    const char* cA = (const char*)g.A + (size_t)cur.pm * tstep + (size_t)cur.z * g.zA; const char* cB = (const char*)g.Bt + (size_t)cur.pn * tstep + (size_t)cur.z * g.zB;
    S.a_ready(cur);
    if constexpr (SP2) {
        PG8_STAGE(PG8_SB(0, 0), cB, voffB); PG8_STAGE(PG8_SB(0, 1), cB + hstep, voffB); PG8_STAGE(PG8_SA(0, 0), cA, voffA); PG8_STAGE(PG8_SA(0, 1), cA + hstep, voffA);
        if (wr == 1) PG8_BAR;
        PG8_WAIT_V(2); PG8_BAR;
        PG8_STAGE(PG8_SB(1, 0), cB + kstep, voffB); PG8_STAGE(PG8_SA(1, 0), cA + kstep, voffA); PG8_STAGE(PG8_SB(1, 1), cB + hstep + kstep, voffB);
        PG8_WAIT_V(6); PG8_BAR;
    } else {
        PG8_STAGE(PG8_SB(0, 0), cB, voffB); PG8_STAGE(PG8_SA(0, 0), cA, voffA); PG8_STAGE(PG8_SB(0, 1), cB + hstep, voffB); PG8_STAGE(PG8_SA(0, 1), cA + hstep, voffA);
        if (wr == 1) PG8_BAR;
        PG8_WAIT_V(4); PG8_BAR;
        PG8_STAGE(PG8_SB(1, 0), cB + kstep, voffB); PG8_STAGE(PG8_SA(1, 0), cA + kstep, voffA); PG8_STAGE(PG8_SB(1, 1), cB + hstep + kstep, voffB);
        PG8_WAIT_V(6); PG8_BAR;
    }
    for (;;) {
        const bool has_next = S.next(ui + 1, nxt);
        const char* nA = has_next ? (const char*)g.A + (size_t)nxt.pm * tstep + (size_t)nxt.z * g.zA : cA; const char* nB = has_next ? (const char*)g.Bt + (size_t)nxt.pn * tstep + (size_t)nxt.z * g.zB : cB;
        for (int t = 0; t < nt; t += 2) {
            const bool last = (t == nt - 2);
            const char* a1 = cA + (size_t)(t + 1) * kstep;
            const char* a2 = last ? nA : cA + (size_t)(t + 2) * kstep; const char* b2 = last ? nB : cB + (size_t)(t + 2) * kstep;
            const char* a3 = a2 + kstep; const char* b3 = b2 + kstep;
            if (last && has_next) S.a_ready(nxt);
            if constexpr (SP2) {
            PG8_LDB(B0, 0, 0); PG8_LDB(B1, 0, 1); PG8_SCHED; PG8_LDA(At, 0, 0); PG8_STAGE(PG8_SA(1, 1), a1 + hstep, voffA);
            PG8_WAIT_V(8); PG8_WAIT_L(0); PG8_BAR; PG8_MMA(0, 0, At, B0); PG8_MMA(0, 1, At, B1); PG8_BAR; PG8_SCHED;
            PG8_LDA(At, 0, 1); PG8_STAGE(PG8_SB(0, 0), b2, voffB); PG8_STAGE(PG8_SB(0, 1), b2 + hstep, voffB); PG8_STAGE(PG8_SA(0, 0), a2, voffA);
            PG8_WAIT_V(8); PG8_WAIT_L(0); PG8_BAR; PG8_MMA(1, 0, At, B0); PG8_MMA(1, 1, At, B1); PG8_BAR; PG8_SCHED;
            PG8_LDB(B0, 1, 0); PG8_LDB(B1, 1, 1); PG8_SCHED; PG8_LDA(At, 1, 0); PG8_STAGE(PG8_SA(0, 1), a2 + hstep, voffA);
            PG8_WAIT_V(8); PG8_WAIT_L(0); PG8_BAR; PG8_MMA(0, 0, At, B0); PG8_MMA(0, 1, At, B1); PG8_BAR; PG8_SCHED;
            PG8_LDA(At, 1, 1); PG8_STAGE(PG8_SB(1, 0), b3, voffB); PG8_STAGE(PG8_SB(1, 1), b3 + hstep, voffB); PG8_STAGE(PG8_SA(1, 0), a3, voffA);
            PG8_WAIT_V(8); PG8_WAIT_L(0); PG8_BAR; PG8_MMA(1, 0, At, B0); PG8_MMA(1, 1, At, B1); PG8_BAR; PG8_SCHED;
            } else {
            PG8_LDB(B0, 0, 0); PG8_SCHED; PG8_LDA(At, 0, 0); PG8_STAGE(PG8_SA(1, 1), a1 + hstep, voffA);
            PG8_WAIT_L(8); PG8_BAR; PG8_WAIT_L(0); PG8_MMA(0, 0, At, B0); PG8_BAR; PG8_SCHED;
            PG8_LDB(B1, 0, 1); PG8_STAGE(PG8_SB(0, 0), b2, voffB);
            PG8_BAR; PG8_WAIT_L(0); PG8_MMA(0, 1, At, B1); PG8_BAR;
            PG8_LDA(At, 0, 1); PG8_STAGE(PG8_SA(0, 0), a2, voffA);
            PG8_BAR; PG8_WAIT_L(0); PG8_MMA(1, 0, At, B0); PG8_BAR; PG8_SCHED;
            PG8_STAGE(PG8_SB(0, 1), b2 + hstep, voffB);
            PG8_WAIT_V(6); PG8_BAR; PG8_MMA(1, 1, At, B1); PG8_BAR;
            PG8_LDB(B0, 1, 0); PG8_SCHED; PG8_LDA(At, 1, 0); PG8_STAGE(PG8_SA(0, 1), a2 + hstep, voffA);
            PG8_WAIT_L(8); PG8_BAR; PG8_WAIT_L(0); PG8_MMA(0, 0, At, B0); PG8_BAR; PG8_SCHED;
            PG8_LDB(B1, 1, 1); PG8_STAGE(PG8_SB(1, 0), b3, voffB);
            PG8_BAR; PG8_WAIT_L(0); PG8_MMA(0, 1, At, B1); PG8_BAR;
            PG8_LDA(At, 1, 1); PG8_STAGE(PG8_SA(1, 0), a3, voffA);
            PG8_BAR; PG8_WAIT_L(0); PG8_MMA(1, 0, At, B0); PG8_BAR; PG8_SCHED;
            PG8_STAGE(PG8_SB(1, 1), b3 + hstep, voffB);
            PG8_WAIT_V(6); PG8_BAR; PG8_MMA(1, 1, At, B1); PG8_BAR;
            }
        }
        if constexpr (ALIGN_EPI) { if (wr == 0) PG8_BAR; }
        if constexpr (!Epi::AFTER_DRAIN) { if constexpr (EpiChain<Epi>::value) E.chain(acc, cur, wr, wc, fr, fq); else E(acc, cur, wr, wc, fr, fq); S.done(cur); }
        if (!has_next) break;
        if (!(EpiChain<Epi>::value && cur.z < 3)) {
#pragma unroll
        for (int a = 0; a < 2; ++a)
#pragma unroll
            for (int b = 0; b < 2; ++b)
#pragma unroll
                for (int m = 0; m < 4; ++m)
#pragma unroll
                    for (int n = 0; n < 2; ++n) acc[a][b][m][n] = (f32x4){0.f, 0.f, 0.f, 0.f};
        }
        cur = nxt; cA = nA; cB = nB; ++ui;
        if constexpr (ALIGN_EPI) { if (wr == 1) PG8_BAR; }
    }
    PG8_WAIT_V(0);
    if constexpr (!ALIGN_EPI) { if (wr == 0) PG8_BAR; }
    PG8_BAR;
    if constexpr (Epi::AFTER_DRAIN) { E.fused(acc, cur, wr, wc, fr, fq, lds, wid, lane); S.done(cur); }
#undef PG8_SA
#undef PG8_SB
#undef PG8_STAGE
#undef PG8_LDA
#undef PG8_LDB
#undef PG8_MMA
#undef PG8_WAIT_V
#undef PG8_WAIT_L
#undef PG8_BAR
#undef PG8_SCHED
}
}

constexpr int AT_PITCH = 160;
constexpr int AT_BUF = 256 * AT_PITCH;
constexpr int AT_RPB = 3 * AT_BUF;
__device__ __forceinline__ float max3f(float a, float b, float c) { float r; asm("v_max3_f32 %0, %1, %2, %3" : "=v"(r) : "v"(a), "v"(b), "v"(c)); return r; }
#define MFMA16(a, b, c) __builtin_amdgcn_mfma_f32_16x16x32_bf16((a), (b), (c), 0, 0, 0)

template <int NS, int DV, class MaskF>
__device__ __forceinline__ void attn_step(const LAS unsigned char* bufK, const LAS unsigned char* bufV, const int (&kslot)[NS], int vrow0, const bf16x8 (&qf)[NS][2],
                                          f32x4 (&o)[NS][DV / 16], float (&mrun)[NS], float (&lrun)[NS], bf16x8 (&pkp)[NS][2], bool masked, bool first, const MaskF& mf, int lane) {
    const int fr = lane & 15, g = lane >> 4;
    f32x4 s[NS][4];
#pragma unroll
    for (int st = 0; st < NS; ++st)
#pragma unroll
        for (int kt = 0; kt < 4; ++kt) {
            const LAS unsigned char* kp = bufK + (kslot[st] * 64 + kt * 16 + fr) * AT_PITCH + g * 16;
            const bf16x8 a0 = *(const LAS bf16x8*)kp, a1 = *(const LAS bf16x8*)(kp + 64);
            const float nm = -mrun[st];
            f32x4 z = {nm, nm, nm, nm};
            z = MFMA16(a0, qf[st][0], z); z = MFMA16(a1, qf[st][1], z);
            s[st][kt] = z;
        }
    if (masked) {
#pragma unroll
        for (int st = 0; st < NS; ++st)
#pragma unroll
            for (int kt = 0; kt < 4; ++kt)
#pragma unroll
                for (int i = 0; i < 4; ++i) s[st][kt][i] = mf(s[st][kt][i], st, kt * 16 + g * 4 + i);
    } else {
        __builtin_amdgcn_sched_group_barrier(0x100, 4, 0);
#pragma unroll
        for (int i = 0; i < NS * 8; ++i) { __builtin_amdgcn_sched_group_barrier(0x008, 1, 0); __builtin_amdgcn_sched_group_barrier(0x100, 1, 0); }
    }
    __builtin_amdgcn_sched_barrier(0);
    float mxs[NS]; bool slow = first;
#pragma unroll
    for (int st = 0; st < NS; ++st) {
        float mx = max3f(s[st][0][0], s[st][0][1], s[st][0][2]);
        mx = max3f(mx, s[st][0][3], s[st][1][0]); mx = max3f(mx, s[st][1][1], s[st][1][2]); mx = max3f(mx, s[st][1][3], s[st][2][0]);
        mx = max3f(mx, s[st][2][1], s[st][2][2]); mx = max3f(mx, s[st][2][3], s[st][3][0]); mx = max3f(mx, s[st][3][1], s[st][3][2]); mx = max3f(mx, s[st][3][3], mx);
        mx = max3f(mx, __shfl_xor(mx, 16), mx); mx = max3f(mx, __shfl_xor(mx, 32), mx);
        mxs[st] = mx; slow = slow || (mx > 8.0f);
    }
    if (__any(slow)) {
#pragma unroll
        for (int dt = 0; dt < DV / 16; ++dt)
#pragma unroll
            for (int j = 0; j < 2; ++j) {
                const bf16x8 va = *(const LAS bf16x8*)(bufV + (128 + vrow0 + dt * 16 + fr) * AT_PITCH + (j * 32 + g * 8) * 2);
#pragma unroll
                for (int st = 0; st < NS; ++st) o[st][dt] = MFMA16(va, pkp[st][j], o[st][dt]);
            }
#pragma unroll
        for (int st = 0; st < NS; ++st) {
            const float d = mxs[st] < -1e20f ? 0.f : (first ? mxs[st] : fmaxf(mxs[st], 0.f));
            mrun[st] += d; const float alpha = ex2(-d);
            lrun[st] *= alpha;
#pragma unroll
            for (int kt = 0; kt < 4; ++kt) s[st][kt] = s[st][kt] - d;
#pragma unroll
            for (int dt = 0; dt < DV / 16; ++dt) o[st][dt] = o[st][dt] * alpha;
            pkp[st][0] = (bf16x8){0, 0, 0, 0, 0, 0, 0, 0}; pkp[st][1] = pkp[st][0];
        }
    }
    __builtin_amdgcn_sched_barrier(0);
    {
        bf16x8 pkn[NS][2];
#pragma unroll
        for (int st = 0; st < NS; ++st) {
            float ps = 0.f;
#pragma unroll
            for (int kt = 0; kt < 4; ++kt)
#pragma unroll
                for (int i = 0; i < 4; ++i) { const float p = ex2(s[st][kt][i]); ps += p; s[st][kt][i] = p; }
            lrun[st] += ps;
#pragma unroll
            for (int j = 0; j < 2; ++j) {
                u32x4 w; w.x = pk2(s[st][2 * j][0], s[st][2 * j][1]); w.y = pk2(s[st][2 * j][2], s[st][2 * j][3]);
                w.z = pk2(s[st][2 * j + 1][0], s[st][2 * j + 1][1]); w.w = pk2(s[st][2 * j + 1][2], s[st][2 * j + 1][3]);
                pkn[st][j] = __builtin_bit_cast(bf16x8, w);
            }
        }
#pragma unroll
        for (int dt = 0; dt < DV / 16; ++dt)
#pragma unroll
            for (int j = 0; j < 2; ++j) {
                const bf16x8 va = *(const LAS bf16x8*)(bufV + (128 + vrow0 + dt * 16 + fr) * AT_PITCH + (j * 32 + g * 8) * 2);
#pragma unroll
                for (int st = 0; st < NS; ++st) o[st][dt] = MFMA16(va, pkp[st][j], o[st][dt]);
            }
#pragma unroll
        for (int st = 0; st < NS; ++st) { pkp[st][0] = pkn[st][0]; pkp[st][1] = pkn[st][1]; }
        __builtin_amdgcn_sched_group_barrier(0x100, 4, 0);
#pragma unroll
        for (int i = 0; i < NS * (DV / 16) * 2; ++i) {
            __builtin_amdgcn_sched_group_barrier(0x008, 1, 0);
            __builtin_amdgcn_sched_group_barrier(0x100, 1, 0);
            __builtin_amdgcn_sched_group_barrier(0x002, NS == 2 && DV == 128 ? 3 : 4, 0);
        }
    }
    __builtin_amdgcn_sched_barrier(0);
}
template <int NS, int DV>
__device__ __forceinline__ void attn_flush(const LAS unsigned char* bufV, int vrow0, f32x4 (&o)[NS][DV / 16], const bf16x8 (&pkp)[NS][2], int lane) {
    const int fr = lane & 15, g = lane >> 4;
#pragma unroll
    for (int dt = 0; dt < DV / 16; ++dt)
#pragma unroll
        for (int j = 0; j < 2; ++j) {
            const bf16x8 va = *(const LAS bf16x8*)(bufV + (128 + vrow0 + dt * 16 + fr) * AT_PITCH + (j * 32 + g * 8) * 2);
#pragma unroll
            for (int st = 0; st < NS; ++st) o[st][dt] = MFMA16(va, pkp[st][j], o[st][dt]);
        }
}

struct NoMask { __device__ __forceinline__ float operator()(float s, int, int) const { return s; } };
struct SwaMask { int qp, pos0; __device__ __forceinline__ float operator()(float s, int, int kl) const { const int d = pos0 + kl - qp; return (d <= 128 && d >= -128) ? s : -1e30f; } };
struct NaMask { int qc, cs, ro31; const LAS float* tab; __device__ __forceinline__ float operator()(float s, int, int kc) const {
    const bool ok = (kc >= cs) && (kc < cs + 16); const int co = kc - qc + 15; const float bias = tab[ro31 + (ok ? co : 15)]; return ok ? s + bias : -1e30f; } };

__device__ __forceinline__ void load_qfrag(const bf16* Pm, int row, int col, int g, float qscale, bf16x8 (&qf)[2]) {
#pragma unroll
    for (int kk = 0; kk < 2; ++kk) {
        const u32x4 w = *(const u32x4*)(Pm + (size_t)row * LDP + col + kk * 32 + g * 8);
        u32x4 r; r.x = pk2(lo16(w.x) * qscale, hi16(w.x) * qscale); r.y = pk2(lo16(w.y) * qscale, hi16(w.y) * qscale);
        r.z = pk2(lo16(w.z) * qscale, hi16(w.z) * qscale); r.w = pk2(lo16(w.w) * qscale, hi16(w.w) * qscale);
        qf[kk] = __builtin_bit_cast(bf16x8, r);
    }
}

template <int MODE>
__device__ __forceinline__ void attn_unit(const Params& p, int layer, LAS unsigned char* lds, int b, int hsel, int qb, bool ctxq) {
    constexpr int NS = MODE == 2 ? 1 : 2;
    constexpr int DV = MODE == 0 ? 128 : 64;
    constexpr int NBATCH = MODE == 1 ? 2 : 4;
    const int tid = tid_opaque(), lane = tid & 63, w = __builtin_amdgcn_readfirstlane(tid >> 6), fr = lane & 15, g = lane >> 4;
    const bf16* Pm = (const bf16*)(p.ws + WS_P);
    const bf16* VT = (const bf16*)(p.ws + WS_VT);
    const float qscale = 0.125f * LOG2E;
    const bf16 *Kb0, *Kb1, *Vb; int qrow, nmask = 0;
    if (MODE == 0) { Kb0 = Pm + C_AK + hsel * 128; Kb1 = Kb0 + 64; Vb = VT + (size_t)(b * NVC + hsel * 128) * NKEY;
        qrow = (ctxq ? MLAT + b * CTXL : b * SEQ) + qb * 128 + w * 16 + fr; nmask = ctxq ? 0 : 128; }
    else if (MODE == 1) { Kb0 = Pm + C_SK + hsel * 64; Kb1 = Kb0; Vb = VT + (size_t)(b * NVC + 512 + hsel * 64) * NKEY;
        qrow = (ctxq ? MLAT + b * CTXL : b * SEQ) + qb * 64 + (w & 3) * 16 + fr; }
    else { Kb0 = Pm + C_NK + hsel * 128; Kb1 = Kb0 + 64; Vb = VT + (size_t)(b * NVC + 640 + hsel * 128) * NKEY;
        qrow = (ctxq ? MLAT + b * CTXL : b * SEQ) + qb * 64 + (w & 3) * 16 + fr; }
    int jb0 = 0, rs = 0;
    if (MODE == 1 && !ctxq) { jb0 = qb > 2 ? qb - 2 : 0; const int jb1 = qb < 125 ? qb + 2 : 127; nmask = jb1 - jb0 + 1; }
    if (MODE == 2 && !ctxq) { rs = qb - 4; rs = rs < 0 ? 0 : (rs > 120 ? 120 : rs); nmask = 8; }
    const int ntile = nmask + 4;
    auto tile_rows = [&](int t, int& keyrow0, int& vkey0) {
        if (t >= nmask) { const int j = t - nmask; keyrow0 = MLAT + b * CTXL + j * 64; vkey0 = SEQ + j * 64; }
        else if (MODE == 0) { keyrow0 = b * SEQ + t * 64; vkey0 = t * 64; }
        else if (MODE == 1) { vkey0 = (jb0 + t) * 64; keyrow0 = b * SEQ + vkey0; }
        else { vkey0 = (rs + t) * 64; keyrow0 = b * SEQ + vkey0; }
    };
    bf16x8 qf[NS][2];
    int kslot[NS]; int vrow0 = 0;
    if (MODE == 0) { load_qfrag(Pm, qrow, C_AQ + hsel * 128, g, qscale, qf[0]); load_qfrag(Pm, qrow, C_AQ + hsel * 128 + 64, g, qscale, qf[NS > 1 ? 1 : 0]); kslot[0] = 0; kslot[NS > 1 ? 1 : 0] = 1; }
    else if (MODE == 1) {
#pragma unroll
        for (int st = 0; st < NS; ++st) { load_qfrag(Pm, qrow, C_SQ + (hsel * 4 + (w >> 2) * 2 + st) * 64, g, qscale, qf[st]); kslot[st] = 0; } }
    else { const int hh = w >> 2; load_qfrag(Pm, qrow, C_NQ + (hsel * 2 + hh) * 64, g, qscale, qf[0]); kslot[0] = hh; vrow0 = hh * 64; }
    f32x4 o[NS][DV / 16]; float mrun[NS], lrun[NS];
#pragma unroll
    for (int st = 0; st < NS; ++st) { mrun[st] = 0.f; lrun[st] = 0.f;
#pragma unroll
        for (int dt = 0; dt < DV / 16; ++dt) o[st][dt] = (f32x4){0.f, 0.f, 0.f, 0.f}; }
    u32x4 treg[NBATCH];
    const int lrow = tid >> 3, lch = tid & 7;
    auto issue = [&](int t) {
        int keyrow0, vkey0; tile_rows(t, keyrow0, vkey0);
        if (MODE == 1) {
            treg[0] = *(const u32x4*)(Kb0 + (size_t)(keyrow0 + lrow) * LDP + lch * 8);
            treg[1] = *(const u32x4*)(Vb + (size_t)lrow * NKEY + vkey0 + lch * 8);
        } else {
            treg[0] = *(const u32x4*)(Kb0 + (size_t)(keyrow0 + lrow) * LDP + lch * 8);
            treg[1] = *(const u32x4*)(Kb1 + (size_t)(keyrow0 + lrow) * LDP + lch * 8);
            treg[2] = *(const u32x4*)(Vb + (size_t)lrow * NKEY + vkey0 + lch * 8);
            treg[NBATCH - 1] = *(const u32x4*)(Vb + (size_t)(64 + lrow) * NKEY + vkey0 + lch * 8);
        }
    };
    auto commit = [&](int bufi) {
        LAS unsigned char* bp = lds + bufi * AT_BUF + lrow * AT_PITCH + lch * 16;
        if (MODE == 1) { *(LAS u32x4*)bp = treg[0]; *(LAS u32x4*)(bp + 128 * AT_PITCH) = treg[1]; }
        else { *(LAS u32x4*)bp = treg[0]; *(LAS u32x4*)(bp + 64 * AT_PITCH) = treg[1]; *(LAS u32x4*)(bp + 128 * AT_PITCH) = treg[2]; *(LAS u32x4*)(bp + 192 * AT_PITCH) = treg[NBATCH - 1]; }
    };
    __syncthreads();
    if (MODE == 2 && !ctxq) {
        const float* rpb = p.in[I_RPB] + (size_t)layer * 8 * 465 + (size_t)(hsel * 2) * 465;
        LAS float* tab = (LAS float*)(lds + AT_RPB);
        for (int i = tid; i < 930; i += NT) tab[i] = rpb[i] * LOG2E;
    }
    issue(0); commit(0);
    issue(1);
    __syncthreads();
    const int qpos = qb * 64 + (w & 3) * 16 + fr;
    const int qc = (w & 3) * 16 + fr;
    int cs = qc - 8; cs = cs < 0 ? 0 : (cs > 48 ? 48 : cs);
    bf16x8 pkp[NS][2];
#pragma unroll
    for (int st = 0; st < NS; ++st) { pkp[st][0] = (bf16x8){0, 0, 0, 0, 0, 0, 0, 0}; pkp[st][1] = pkp[st][0]; }
    int bcur = 0, bprev = 0;
    for (int t = 0; t < ntile; ++t) {
        const int bnext = bcur == 2 ? 0 : bcur + 1;
        if (t + 1 < ntile) commit(bnext);
        if (t + 2 < ntile) issue(t + 2);
        const LAS unsigned char* bufK = lds + bcur * AT_BUF; const LAS unsigned char* bufV = lds + bprev * AT_BUF;
        const bool masked = (MODE != 0) && (t < nmask);
        if (MODE == 1) { SwaMask mf{qpos, (jb0 + t) * 64}; attn_step<NS, DV>(bufK, bufV, kslot, vrow0, qf, o, mrun, lrun, pkp, masked, t == 0, mf, lane); }
        else if (MODE == 2) { NaMask mf{qc, cs, ((w >> 2) * 465) + (rs + t - qb + 7) * 31, (const LAS float*)(lds + AT_RPB)}; if (!masked) mf.ro31 = 0;
            attn_step<NS, DV>(bufK, bufV, kslot, vrow0, qf, o, mrun, lrun, pkp, masked, t == 0, mf, lane); }
        else { NoMask mf; attn_step<NS, DV>(bufK, bufV, kslot, vrow0, qf, o, mrun, lrun, pkp, false, t == 0, mf, lane); }
        bprev = bcur; bcur = bnext;
        __syncthreads();
    }
    attn_flush<NS, DV>(lds + bprev * AT_BUF, vrow0, o, pkp, lane);
    float ltot[NS];
#pragma unroll
    for (int st = 0; st < NS; ++st) {
        float l = lrun[st];
        if (MODE == 1) { if (g == 0) l += ex2(p.in[I_SINK][layer * 8 + hsel * 4 + (w >> 2) * 2 + st] * LOG2E - mrun[st]); }
        l += __shfl_xor(l, 16); l += __shfl_xor(l, 32); ltot[st] = 1.0f / l;
    }
    bf16* YS = (bf16*)(p.ws + WS_YS);
    if (MODE == 0) {
        const float lam = ((const float*)(p.ws + WS_LAM))[layer];
        const float lam_init = 0.8f - 0.6f * __expf(-0.3f * (float)layer);
        const float* gs = p.in[I_GSUBLN] + layer * 128;
        f32x4 r[DV / 16]; float ss = 0.f;
#pragma unroll
        for (int dt = 0; dt < DV / 16; ++dt) { r[dt] = o[0][dt] * ltot[0] - o[NS > 1 ? 1 : 0][dt] * (lam * ltot[NS > 1 ? 1 : 0]); ss += (r[dt][0] * r[dt][0] + r[dt][1] * r[dt][1]) + (r[dt][2] * r[dt][2] + r[dt][3] * r[dt][3]); }
        ss += __shfl_xor(ss, 16); ss += __shfl_xor(ss, 32);
        const float rstd = (1.0f - lam_init) / sqrtf(ss * (1.0f / 128.0f) + EPS);
        bf16* orow = YS + (size_t)qrow * 512 + hsel * 128;
#pragma unroll
        for (int dt = 0; dt < DV / 16; ++dt) { const f32x4 gv = *(const f32x4*)(gs + dt * 16 + g * 4);
            u32x2 wv; wv.x = pk2(r[dt][0] * rstd * gv[0], r[dt][1] * rstd * gv[1]); wv.y = pk2(r[dt][2] * rstd * gv[2], r[dt][3] * rstd * gv[3]);
            *(u32x2*)(orow + dt * 16 + g * 4) = wv; }
    } else {
#pragma unroll
        for (int st = 0; st < NS; ++st) {
            bf16* orow = (MODE == 1) ? YS + (size_t)2 * MALL * 512 + (size_t)qrow * 512 + (hsel * 4 + (w >> 2) * 2 + st) * 64
                                     : YS + (size_t)3 * MALL * 512 + (size_t)qrow * 512 + (hsel * 2 + (w >> 2)) * 64;
#pragma unroll
            for (int dt = 0; dt < DV / 16; ++dt) { const f32x4 v = o[st][dt] * ltot[st];
                u32x2 wv; wv.x = pk2(v[0], v[1]); wv.y = pk2(v[2], v[3]); *(u32x2*)(orow + dt * 16 + g * 4) = wv; }
        }
    }
}

constexpr int XT_PITCH = 264;
constexpr int BN_PITCH = 272;
constexpr int SS_XT = 0, SS_B = 256 * XT_PITCH  , SS_C = SS_B + 128 * BN_PITCH  , SS_T0 = SS_C + 128 * BN_PITCH  , SS_T1 = SS_T0 + 4096, SS_TOT = SS_T1 + 4096;
static_assert(SS_TOT + 64 <= LDS_BYTES, "ssd lds");

__device__ __forceinline__ float softplusf_(float x) { return fmaxf(x, 0.f) + log1pf(__expf(-fabsf(x))); }

template <class Put>
__device__ __forceinline__ void conv_pair32(const bf16* Pseq  , int L, int p0, int xch, const float* cw, const float* cb, const Put& put) {
    float w0[5], w1[5];
#pragma unroll
    for (int k = 0; k < 5; ++k) { w0[k] = cw[k * 1024 + xch]; w1[k] = cw[k * 1024 + xch + 1]; }
    const float b0 = cb[xch], b1 = cb[xch + 1];
    float a0 = 0.f, a1 = 0.f, a2 = 0.f, a3 = 0.f, a4 = 0.f, c0 = 0.f, c1 = 0.f, c2 = 0.f, c3 = 0.f, c4 = 0.f;
#pragma unroll
    for (int i = 0; i < 36; ++i) {
        const int pos = p0 + i - 2;
        unsigned raw = 0u;
        if (pos >= 0 && pos < L) raw = *(const unsigned*)(Pseq + (size_t)pos * LDP + xch);
        a0 = a1; a1 = a2; a2 = a3; a3 = a4; a4 = lo16(raw);
        c0 = c1; c1 = c2; c2 = c3; c3 = c4; c4 = hi16(raw);
        if (i >= 4) {
            const float v0 = b0 + w0[0] * a0 + w0[1] * a1 + w0[2] * a2 + w0[3] * a3 + w0[4] * a4;
            const float v1 = b1 + w1[0] * c0 + w1[1] * c1 + w1[2] * c2 + w1[3] * c3 + w1[4] * c4;
            put(i - 4, siluf_(v0), siluf_(v1));
        }
    }
}

struct SsdGeo { int R0, Rseq0, L, pos0; };
__device__ __forceinline__ SsdGeo ssd_geo(int b, int cc) {
    SsdGeo G;
    if (cc < 2) { G.Rseq0 = MLAT + b * CTXL; G.L = CTXL; G.pos0 = cc * 128; }
    else { G.Rseq0 = b * SEQ; G.L = SEQ; G.pos0 = (cc - 2) * 128; }
    G.R0 = G.Rseq0 + G.pos0; return G;
}

__device__ __forceinline__ void ssd_dt_scan(const Params& p, int layer, const bf16* Pm, int R0, int head, int dir, int lane, float (&dt)[2], float (&a)[2], float (&incl)[2], float& total) {
    const float bias = p.in[I_DTBIAS][layer * 16 + dir * 8 + head];
    const float A = -__expf(p.in[I_ALOG][layer * 16 + dir * 8 + head]);
#pragma unroll
    for (int e = 0; e < 2; ++e) { const float raw = bf2f(Pm[(size_t)(R0 + 2 * lane + e) * LDP + C_BDT + dir * 8 + head]); dt[e] = softplusf_(raw + bias); a[e] = dt[e] * A; }
    float s = a[0] + a[1];
#pragma unroll
    for (int off = 1; off < 64; off <<= 1) { const float t = __shfl_up(s, off); if (lane >= off) s += t; }
    const float excl = s - (a[0] + a[1]);
    incl[0] = excl + a[0]; incl[1] = incl[0] + a[1];
    total = __shfl(s, 63);
}

__device__ __forceinline__ void ssd_state_unit(const Params& p, int layer, LAS unsigned char* lds, int b, int cc, int g) {
    const int tid = tid_opaque(), lane = tid & 63, w = __builtin_amdgcn_readfirstlane(tid >> 6), fr = lane & 15, fq = lane >> 4;
    const bf16* Pm = (const bf16*)(p.ws + WS_P);
    const SsdGeo G = ssd_geo(b, cc);
    const float* cw = p.in[I_CONVW] + (size_t)layer * 5 * 1024; const float* cb = p.in[I_CONVB] + layer * 1024;
    __syncthreads();
    for (int it = tid; it < 192 * 4; it += NT) {
        const int pr = it % 192, q = it / 192, c0 = pr * 2;
        const bool isx = c0 < 256;
        const int xch = isx ? g * 256 + c0 : 512 + g * 128 + (c0 - 256);
        LAS unsigned char* dst = isx ? lds + SS_XT + c0 * XT_PITCH : lds + SS_B + (c0 - 256) * BN_PITCH;
        const int pitch = isx ? XT_PITCH : BN_PITCH;
        conv_pair32(Pm + (size_t)G.Rseq0 * LDP + C_BX, G.L, G.pos0 + q * 32, xch, cw, cb, [&](int l, float v0, float v1) {
            const unsigned pk = pk2(v0, v1); const int ll = q * 32 + l;
            *(LAS unsigned short*)(dst + ll * 2) = (unsigned short)(pk & 0xffffu); *(LAS unsigned short*)(dst + pitch + ll * 2) = (unsigned short)(pk >> 16); });
    }
    const int h4 = w >> 1, dir = w & 1, head = g * 4 + h4;
    {
        float dt[2], a[2], incl[2], total;
        ssd_dt_scan(p, layer, Pm, G.R0, head, dir, lane, dt, a, incl, total);
        LAS float* wt = (LAS float*)(lds + SS_T0) + w * 128;
#pragma unroll
        for (int e = 0; e < 2; ++e) wt[2 * lane + e] = dir == 0 ? dt[e] * __expf(total - incl[e]) : dt[e] * __expf(incl[e] - a[e]);
        if (lane == 0) ((float*)(p.ws + WS_DEC))[((b * NCH + cc) * 2 + dir) * 8 + head] = __expf(total);
    }
    __syncthreads();
    float* ST = (float*)(p.ws + WS_ACT) + (size_t)(((b * NCH + cc) * 2 + dir) * 8 + head) * 8192;
#pragma unroll 1
    for (int sh = 0; sh < 2; ++sh) {
        f32x4 acc[4][4];
#pragma unroll
        for (int pt = 0; pt < 4; ++pt)
#pragma unroll
            for (int st = 0; st < 4; ++st) acc[pt][st] = (f32x4){0.f, 0.f, 0.f, 0.f};
#pragma unroll
        for (int ks = 0; ks < 4; ++ks) {
            const LAS float* wt = (const LAS float*)(lds + SS_T0) + w * 128 + ks * 32 + fq * 8;
            const f32x4 wa = *(const LAS f32x4*)wt, wb = *(const LAS f32x4*)(wt + 4);
            bf16x8 bfr[4];
#pragma unroll
            for (int st = 0; st < 4; ++st) bfr[st] = *(const LAS bf16x8*)(lds + SS_B + ((sh * 4 + st) * 16 + fr) * BN_PITCH + (ks * 32 + fq * 8) * 2);
#pragma unroll
            for (int pt = 0; pt < 4; ++pt) {
                const LAS unsigned char* xp = lds + SS_XT + (h4 * 64 + pt * 16 + fr) * XT_PITCH + (ks * 32 + fq * 8) * 2;
                const u32x2 x0 = *(const LAS u32x2*)xp, x1 = *(const LAS u32x2*)(xp + 8);
                u32x4 af; af.x = pk2(lo16(x0.x) * wa[0], hi16(x0.x) * wa[1]); af.y = pk2(lo16(x0.y) * wa[2], hi16(x0.y) * wa[3]);
                af.z = pk2(lo16(x1.x) * wb[0], hi16(x1.x) * wb[1]); af.w = pk2(lo16(x1.y) * wb[2], hi16(x1.y) * wb[3]);
                const bf16x8 afv = __builtin_bit_cast(bf16x8, af);
#pragma unroll
                for (int st = 0; st < 4; ++st) acc[pt][st] = MFMA16(afv, bfr[st], acc[pt][st]);
            }
        }
#pragma unroll
        for (int pt = 0; pt < 4; ++pt)
#pragma unroll
            for (int st = 0; st < 4; ++st)
#pragma unroll
                for (int i = 0; i < 4; ++i) ST[(pt * 16 + fq * 4 + i) * 128 + (sh * 4 + st) * 16 + fr] = acc[pt][st][i];
    }
}

__device__ __forceinline__ void ssd_scan_phase(const Params& p) {
    const int gt = blockIdx.x * NT + tid_opaque(), GT = gridDim.x * NT;
    const float* DEC = (const float*)(p.ws + WS_DEC);
    for (int idx = gt; idx < NB * 2 * 8 * 64 * 64; idx += GT) {
        const int s2 = idx & 63, pp = (idx >> 6) & 63, head = (idx >> 12) & 7, dir = (idx >> 15) & 1, b = idx >> 16;
        f32x2 h = {0.f, 0.f};
        unsigned* HPB = (unsigned*)(p.ws + WS_HPB);
        for (int s0 = 0; s0 < NCH; s0 += 6) {
            f32x2 v[6]; float dc[6]; size_t off[6];
#pragma unroll
            for (int k = 0; k < 6; ++k) { const int s = s0 + k; const int cc = dir == 0 ? s : (s == 0 ? 1 : (s == 1 ? 0 : 67 - s));
                off[k] = ((size_t)(((b * NCH + cc) * 2 + dir) * 8 + head) * 64 + pp) * 128 + s2 * 2;
                v[k] = *(const f32x2*)((const float*)(p.ws + WS_ACT) + off[k]); dc[k] = DEC[((b * NCH + cc) * 2 + dir) * 8 + head]; }
#pragma unroll
            for (int k = 0; k < 6; ++k) { HPB[off[k] >> 1] = pk2(h[0], h[1]); h = h * dc[k] + v[k]; }
        }
    }
}

__device__ __forceinline__ void ssd_out_unit(const Params& p, int layer, LAS unsigned char* lds, int b, int cc, int g, bool do_ssq = true) {
    const int tid = tid_opaque(), lane = tid & 63, w = __builtin_amdgcn_readfirstlane(tid >> 6), fr = lane & 15, fq = lane >> 4;
    const bf16* Pm = (const bf16*)(p.ws + WS_P);
    const SsdGeo G = ssd_geo(b, cc);
    const float* cw = p.in[I_CONVW] + (size_t)layer * 5 * 1024; const float* cb = p.in[I_CONVB] + layer * 1024;
    __syncthreads();
    for (int it = tid; it < 256 * 4; it += NT) {
        const int pr = it & 255, q = it >> 8, c0 = pr * 2;
        if (c0 < 256) {
            LAS unsigned char* dst = lds + SS_XT + c0 * XT_PITCH;
            conv_pair32(Pm + (size_t)G.Rseq0 * LDP + C_BX, G.L, G.pos0 + q * 32, g * 256 + c0, cw, cb, [&](int l, float v0, float v1) {
                const unsigned pk = pk2(v0, v1); const int ll = q * 32 + l;
                *(LAS unsigned short*)(dst + ll * 2) = (unsigned short)(pk & 0xffffu); *(LAS unsigned short*)(dst + XT_PITCH + ll * 2) = (unsigned short)(pk >> 16); });
        } else {
            const int n0 = (c0 - 256) & 127; const bool isC = (c0 - 256) >= 128;
            LAS unsigned char* dst = lds + (isC ? SS_C : SS_B) + n0 * 2;
            conv_pair32(Pm + (size_t)G.Rseq0 * LDP + C_BX, G.L, G.pos0 + q * 32, 512 + (isC ? 256 : 0) + g * 128 + n0, cw, cb, [&](int l, float v0, float v1) {
                *(LAS unsigned*)(dst + (q * 32 + l) * BN_PITCH) = pk2(v0, v1); });
        }
    }
    {
        const int h4 = w >> 1, dir = w & 1;
        float dt[2], a[2], incl[2], total;
        ssd_dt_scan(p, layer, Pm, G.R0, g * 4 + h4, dir, lane, dt, a, incl, total);
        LAS float* t0 = (LAS float*)(lds + SS_T0) + w * 128; LAS float* t1 = (LAS float*)(lds + SS_T1) + w * 128;
#pragma unroll
        for (int e = 0; e < 2; ++e) { t0[2 * lane + e] = dir == 0 ? incl[e] : incl[e] - a[e]; t1[2 * lane + e] = dt[e]; }
        if (lane == 0) ((LAS float*)(lds + SS_TOT))[w] = total;
    }
    __syncthreads();
    const int h4 = w & 3, lh = w >> 2, head = g * 4 + h4;
    const float dsk = p.in[I_DSKIP][layer * 8 + head];
    bf16* Yb = (bf16*)(p.ws + WS_YS) + (size_t)1 * MALL * 512;
    float* SSQ = (float*)(p.ws + WS_SSQ);
#pragma unroll 1
    for (int lp = 0; lp < 2; ++lp) {
    const int lt0 = lh * 4 + lp * 2;
    f32x4 acc[4][2];
#pragma unroll
    for (int pt = 0; pt < 4; ++pt)
#pragma unroll
        for (int lt = 0; lt < 2; ++lt) acc[pt][lt] = (f32x4){0.f, 0.f, 0.f, 0.f};
#pragma unroll 1
    for (int dir = 0; dir < 2; ++dir) {
        const bf16* HP = (const bf16*)(p.ws + WS_HPB) + (size_t)(((b * NCH + cc) * 2 + dir) * 8 + head) * 8192;
        const LAS float* t0 = (const LAS float*)(lds + SS_T0) + (h4 * 2 + dir) * 128;
        const float tot = ((const LAS float*)(lds + SS_TOT))[h4 * 2 + dir];
        bf16x8 hf[4][4];
#pragma unroll
        for (int pt = 0; pt < 4; ++pt)
#pragma unroll
            for (int ks = 0; ks < 4; ++ks) hf[pt][ks] = *(const bf16x8*)(HP + (pt * 16 + fr) * 128 + ks * 32 + fq * 8);
        float el[2];
#pragma unroll
        for (int lt = 0; lt < 2; ++lt) { const float ea = t0[(lt0 + lt) * 16 + fr]; el[lt] = dir == 0 ? __expf(ea) : __expf(tot - ea); }
#pragma unroll
        for (int ks = 0; ks < 4; ++ks) {
            bf16x8 cf[2];
#pragma unroll
            for (int lt = 0; lt < 2; ++lt) { const u32x4 cw4 = *(const LAS u32x4*)(lds + SS_C + ((lt0 + lt) * 16 + fr) * BN_PITCH + (ks * 32 + fq * 8) * 2);
                u32x4 sw; sw.x = pk2(lo16(cw4.x) * el[lt], hi16(cw4.x) * el[lt]); sw.y = pk2(lo16(cw4.y) * el[lt], hi16(cw4.y) * el[lt]);
                sw.z = pk2(lo16(cw4.z) * el[lt], hi16(cw4.z) * el[lt]); sw.w = pk2(lo16(cw4.w) * el[lt], hi16(cw4.w) * el[lt]);
                cf[lt] = __builtin_bit_cast(bf16x8, sw); }
#pragma unroll
            for (int pt = 0; pt < 4; ++pt)
#pragma unroll
                for (int lt = 0; lt < 2; ++lt) acc[pt][lt] = MFMA16(hf[pt][ks], cf[lt], acc[pt][lt]);
        }
    }
#pragma unroll
    for (int lt = 0; lt < 2; ++lt) {
        const int ltg = lt0 + lt;
        f32x4 cbt[8];
#pragma unroll
        for (int st = 0; st < 8; ++st) cbt[st] = (f32x4){0.f, 0.f, 0.f, 0.f};
#pragma unroll
        for (int ks = 0; ks < 4; ++ks) {
            const bf16x8 cfr = *(const LAS bf16x8*)(lds + SS_C + (ltg * 16 + fr) * BN_PITCH + (ks * 32 + fq * 8) * 2);
#pragma unroll
            for (int st = 0; st < 8; ++st) { const bf16x8 bfr = *(const LAS bf16x8*)(lds + SS_B + (st * 16 + fr) * BN_PITCH + (ks * 32 + fq * 8) * 2);
                cbt[st] = MFMA16(bfr, cfr, cbt[st]); }
        }
        __builtin_amdgcn_sched_barrier(0);
#pragma unroll 1
        for (int dir = 0; dir < 2; ++dir) {
            const LAS float* t0 = (const LAS float*)(lds + SS_T0) + (h4 * 2 + dir) * 128;
            const LAS float* t1 = (const LAS float*)(lds + SS_T1) + (h4 * 2 + dir) * 128;
            const int l = ltg * 16 + fr; const float el = t0[l];
            bf16x8 pk[4];
#pragma unroll
            for (int j = 0; j < 4; ++j) {
                float mv[8];
#pragma unroll
                for (int hh = 0; hh < 2; ++hh) { const int st = 2 * j + hh; const int s0 = st * 16 + fq * 4;
                    const f32x4 es = *(const LAS f32x4*)(t0 + s0), ds = *(const LAS f32x4*)(t1 + s0);
#pragma unroll
                    for (int i = 0; i < 4; ++i) { const int s = s0 + i;
                        const bool ok = dir == 0 ? (s <= l) : (s >= l);
                        const float ex = dir == 0 ? el - es[i] : es[i] - el;
                        mv[hh * 4 + i] = ok ? cbt[st][i] * ds[i] * __expf(fminf(ex, 0.f)) : 0.f; } }
                u32x4 wv; wv.x = pk2(mv[0], mv[1]); wv.y = pk2(mv[2], mv[3]); wv.z = pk2(mv[4], mv[5]); wv.w = pk2(mv[6], mv[7]);
                pk[j] = __builtin_bit_cast(bf16x8, wv);
            }
#pragma unroll
            for (int pt = 0; pt < 4; ++pt)
#pragma unroll
                for (int j = 0; j < 4; ++j) {
                    const LAS unsigned char* xp = lds + SS_XT + (h4 * 64 + pt * 16 + fr) * XT_PITCH + (j * 32 + fq * 4) * 2;
                    const u32x2 x0 = *(const LAS u32x2*)xp, x1 = *(const LAS u32x2*)(xp + 32);
                    u32x4 xv; xv.x = x0.x; xv.y = x0.y; xv.z = x1.x; xv.w = x1.y;
                    acc[pt][lt] = MFMA16(__builtin_bit_cast(bf16x8, xv), pk[j], acc[pt][lt]);
                }
        }
    }
    u32x2 zw8[2][4];
#pragma unroll
    for (int lt = 0; lt < 2; ++lt)
#pragma unroll
        for (int pt = 0; pt < 4; ++pt) zw8[lt][pt] = *(const u32x2*)(Pm + (size_t)(G.R0 + (lt0 + lt) * 16 + fr) * LDP + C_BZ + g * 256 + h4 * 64 + pt * 16 + fq * 4);
#pragma unroll
    for (int lt = 0; lt < 2; ++lt) {
        const int l = (lt0 + lt) * 16 + fr, row = G.R0 + l;
        float ss = 0.f;
#pragma unroll
        for (int pt = 0; pt < 4; ++pt) {
            const int ch = h4 * 64 + pt * 16 + fq * 4;
            const u32x2 zw = zw8[lt][pt];
            const float z[4] = {lo16(zw.x), hi16(zw.x), lo16(zw.y), hi16(zw.y)};
            float y[4];
#pragma unroll
            for (int i = 0; i < 4; ++i) { const float xs = bf2f(*(const LAS unsigned short*)(lds + SS_XT + (ch + i) * XT_PITCH + l * 2));
                y[i] = (acc[pt][lt][i] + dsk * xs) * siluf_(z[i]); ss += y[i] * y[i]; }
            u32x2 wv; wv.x = pk2(y[0], y[1]); wv.y = pk2(y[2], y[3]);
            *(u32x2*)(Yb + (size_t)row * 512 + g * 256 + ch) = wv;
        }
        ss += __shfl_xor(ss, 16); ss += __shfl_xor(ss, 32);
        if (fq == 0 && do_ssq) atomicAdd(SSQ + row, ss);
    }
    }
}

#define LDS_WAIT() asm volatile("s_waitcnt lgkmcnt(0)" ::: "memory")

__device__ __forceinline__ void transpose_item(const float* W, int K, int N, int Npad, bf16* WT, const float* kscale, LAS float* scr, int item, int lane) {
    const int nblk = Npad / 64, kb = item / nblk, nb = item % nblk, k0 = kb * 64, n0 = nb * 64;
    const bool nok = (n0 + lane) < N;
#pragma unroll
    for (int i0 = 0; i0 < 64; i0 += 32) {
        float v[32];
#pragma unroll
        for (int i = 0; i < 32; ++i) v[i] = nok ? W[(size_t)(k0 + i0 + i) * N + n0 + lane] : 0.f;
#pragma unroll
        for (int i = 0; i < 32; ++i) { float t = v[i]; if (kscale) t *= kscale[k0 + i0 + i]; scr[(i0 + i) * 65 + lane] = t; }
    }
    LDS_WAIT();
    const int c = lane & 7;
#pragma unroll
    for (int j = 0; j < 8; ++j) { const int n = (lane >> 3) + 8 * j; const LAS float* s = scr + (8 * c) * 65 + n;
        u32x4 o; o.x = pk2(s[0 * 65], s[1 * 65]); o.y = pk2(s[2 * 65], s[3 * 65]); o.z = pk2(s[4 * 65], s[5 * 65]); o.w = pk2(s[6 * 65], s[7 * 65]);
        *(u32x4*)(WT + (size_t)(n0 + n) * K + k0 + 8 * c) = o; }
    LDS_WAIT();
}

__device__ __forceinline__ void convert_weights(const Params& p, int layer, LAS unsigned char* lds) {
    const int tid_ = tid_opaque(); const int lane = tid_ & 63, wave = tid_ >> 6;
    const int gw = blockIdx.x * 8 + wave, NGW = gridDim.x * 8;
    LAS float* scr = (LAS float*)(lds + wave * 16640);
    unsigned char* wt = p.ws + WS_WT;
    constexpr int I_IN_ = (D / 64) * (LDP / 64), I_BR1 = (512 / 64) * (D / 64), I_O = (D / 64) * (D / 64), I_1 = (D / 64) * (DFF / 64), I_2 = (DFF / 64) * (D / 64);
    constexpr int NITEMS = I_IN_ + 4 * I_BR1 + I_O + I_1 + I_2;
    for (int it = gw; it < NITEMS; it += NGW) {
        int r = it;
        if (r < I_IN_) { transpose_item(p.in[I_WIN] + (size_t)layer * D * INC, D, INC, LDP, (bf16*)(wt + WT_IN), nullptr, scr, r, lane); continue; } r -= I_IN_;
        if (r < 4 * I_BR1) { const int br = r / I_BR1; transpose_item(p.in[I_WBR] + ((size_t)layer * 4 + br) * 512 * D, 512, D, D, (bf16*)(wt + WT_BR) + (size_t)br * D * 512,
                                                                     br == 1 ? p.in[I_GSSM] + layer * 512 : nullptr, scr, r % I_BR1, lane); continue; } r -= 4 * I_BR1;
        if (r < I_O) { transpose_item(p.in[I_WOUT] + (size_t)layer * D * D, D, D, D, (bf16*)(wt + WT_OUT), nullptr, scr, r, lane); continue; } r -= I_O;
        if (r < I_1) { transpose_item(p.in[I_WFF1] + (size_t)layer * D * DFF, D, DFF, DFF, (bf16*)(wt + WT_F1), nullptr, scr, r, lane); continue; } r -= I_1;
        transpose_item(p.in[I_WFF2] + (size_t)layer * DFF * D, DFF, D, D, (bf16*)(wt + WT_F2), nullptr, scr, r, lane);
    }
}

__device__ __forceinline__ void mod_item(const Params& p, int item, LAS unsigned char* lds) {
    const int tid = tid_opaque(); const int layer = item / 96, j0 = (item % 96) * 128;
    LAS float* sc = (LAS float*)lds;
    LAS float* red = (LAS float*)(lds + 24576);
    __syncthreads();
    for (int i = tid; i < 3 * 2048; i += NT) { const int v = i >> 11, k = i & 2047; const float x = v < 2 ? p.in[I_C][v * D + k] : p.in[I_CCTX][k]; sc[i] = siluf_(x); }
    __syncthreads();
    const int c4 = tid & 31, kq = tid >> 5;
    const float* wm = p.in[I_WMOD] + (size_t)layer * D * 12288 + j0 + c4 * 4;
    f32x4 a0 = {0.f, 0.f, 0.f, 0.f}, a1 = a0, a2 = a0;
#pragma unroll 16
    for (int kk = 0; kk < 128; ++kk) { const int k = kq * 128 + kk; const f32x4 wv = *(const f32x4*)(wm + (size_t)k * 12288);
        a0 = a0 + wv * sc[k]; a1 = a1 + wv * sc[2048 + k]; a2 = a2 + wv * sc[4096 + k]; }
#pragma unroll
    for (int e = 0; e < 4; ++e) { red[(kq * 3 + 0) * 128 + c4 * 4 + e] = a0[e]; red[(kq * 3 + 1) * 128 + c4 * 4 + e] = a1[e]; red[(kq * 3 + 2) * 128 + c4 * 4 + e] = a2[e]; }
    __syncthreads();
    if (tid < 384) { const int v = tid >> 7, c = tid & 127; float s = p.in[I_BMOD][layer * 12288 + j0 + c];
#pragma unroll
        for (int q = 0; q < 16; ++q) s += red[(q * 3 + v) * 128 + c];
        ((float*)(p.ws + WS_MOD))[(size_t)(layer * 3 + v) * 12288 + j0 + c] = s; }
    __syncthreads();
}

template <bool HAS_Y, bool WRITE_H>
__device__ __forceinline__ void row_pass(const float* xrow, const bf16* yrow, const float* yrow32, const float* gpost, const float* mgate, float* xout,
                                         const float* gpre, const float* shift, const float* scale, bf16* hrow, int lane) {
    f32x4 x[8];
#pragma unroll
    for (int j = 0; j < 8; ++j) x[j] = *(const f32x4*)(xrow + (j * 64 + lane) * 4);
    if (HAS_Y) {
        f32x4 y[8], gp[8], mg[8]; float ss = 0.f;
#pragma unroll
        for (int j = 0; j < 8; ++j) { if (yrow32) y[j] = *(const f32x4*)(yrow32 + (j * 64 + lane) * 4); else { const u32x2 yw = *(const u32x2*)(yrow + (j * 64 + lane) * 4); y[j] = (f32x4){lo16(yw.x), hi16(yw.x), lo16(yw.y), hi16(yw.y)}; } }
#pragma unroll
        for (int j = 0; j < 8; ++j) { const int e = (j * 64 + lane) * 4; gp[j] = *(const f32x4*)(gpost + e); mg[j] = *(const f32x4*)(mgate + e); }
#pragma unroll
        for (int j = 0; j < 8; ++j) ss += (y[j][0] * y[j][0] + y[j][1] * y[j][1]) + (y[j][2] * y[j][2] + y[j][3] * y[j][3]);
        const float rstd = 1.0f / sqrtf(wave_sum(ss) * (1.0f / D) + EPS);
#pragma unroll
        for (int j = 0; j < 8; ++j) x[j] = x[j] + mg[j] * (y[j] * rstd * gp[j]);
    }
    if (WRITE_H) {
        f32x4 gq[8], sh[8], scl[8];
#pragma unroll
        for (int j = 0; j < 8; ++j) { const int e = (j * 64 + lane) * 4; gq[j] = *(const f32x4*)(gpre + e); sh[j] = *(const f32x4*)(shift + e); scl[j] = *(const f32x4*)(scale + e); }
        if (HAS_Y) {
#pragma unroll
            for (int j = 0; j < 8; ++j) *(f32x4*)(xout + (j * 64 + lane) * 4) = x[j];
        }
        float ss = 0.f;
#pragma unroll
        for (int j = 0; j < 8; ++j) ss += (x[j][0] * x[j][0] + x[j][1] * x[j][1]) + (x[j][2] * x[j][2] + x[j][3] * x[j][3]);
        const float rstd = 1.0f / sqrtf(wave_sum(ss) * (1.0f / D) + EPS);
#pragma unroll
        for (int j = 0; j < 8; ++j) { const int e = (j * 64 + lane) * 4;
            const f32x4 h = (x[j] * rstd * gq[j]) * (scl[j] + 1.0f) + sh[j];
            u32x2 wv; wv.x = pk2(h[0], h[1]); wv.y = pk2(h[2], h[3]); *(u32x2*)(hrow + e) = wv; }
    } else if (HAS_Y) {
#pragma unroll
        for (int j = 0; j < 8; ++j) *(f32x4*)(xout + (j * 64 + lane) * 4) = x[j];
    }
}

__device__ __forceinline__ void rope_phase(const Params& p) {
    bf16* Pm = (bf16*)(p.ws + WS_P);
    const float* COS = (const float*)(p.ws + WS_COS); const float* SIN = (const float*)(p.ws + WS_SIN);
    const int gt = blockIdx.x * NT + tid_opaque(), GT = gridDim.x * NT;
    constexpr int NITEM = MLAT * 26 * 4;
    for (int idx0 = gt; idx0 < NITEM; idx0 += 4 * GT) {
        u32x4 t1[4], t2[4]; f32x4 c0[4], c1[4], s0[4], s1[4]; bf16* q[4];
#pragma unroll
        for (int k = 0; k < 4; ++k) {
            int idx = idx0 + k * GT; if (idx >= NITEM) idx = idx0;
            const int c = idx & 3, hh = (idx >> 2) % 26, row = (idx >> 2) / 26;
            const int col = hh < 8 ? C_AQ + hh * 64 : (hh < 16 ? C_AK + (hh - 8) * 64 : (hh < 24 ? C_SQ + (hh - 16) * 64 : C_SK + (hh - 24) * 64));
            q[k] = Pm + (size_t)row * LDP + col + c * 8;
            const int pos = row & (SEQ - 1);
            t1[k] = *(const u32x4*)q[k]; t2[k] = *(const u32x4*)(q[k] + 32);
            c0[k] = *(const f32x4*)(COS + pos * 32 + c * 8); c1[k] = *(const f32x4*)(COS + pos * 32 + c * 8 + 4);
            s0[k] = *(const f32x4*)(SIN + pos * 32 + c * 8); s1[k] = *(const f32x4*)(SIN + pos * 32 + c * 8 + 4);
        }
#pragma unroll
        for (int k = 0; k < 4; ++k) {
            if (k > 0 && idx0 + k * GT >= NITEM) continue;
            const float a[8] = {lo16(t1[k].x), hi16(t1[k].x), lo16(t1[k].y), hi16(t1[k].y), lo16(t1[k].z), hi16(t1[k].z), lo16(t1[k].w), hi16(t1[k].w)};
            const float bq[8] = {lo16(t2[k].x), hi16(t2[k].x), lo16(t2[k].y), hi16(t2[k].y), lo16(t2[k].z), hi16(t2[k].z), lo16(t2[k].w), hi16(t2[k].w)};
            const float cs[8] = {c0[k][0], c0[k][1], c0[k][2], c0[k][3], c1[k][0], c1[k][1], c1[k][2], c1[k][3]};
            const float sn[8] = {s0[k][0], s0[k][1], s0[k][2], s0[k][3], s1[k][0], s1[k][1], s1[k][2], s1[k][3]};
            float o1[8], o2[8];
#pragma unroll
            for (int e = 0; e < 8; ++e) { o1[e] = a[e] * cs[e] - bq[e] * sn[e]; o2[e] = bq[e] * cs[e] + a[e] * sn[e]; }
            u32x4 w1, w2; w1.x = pk2(o1[0], o1[1]); w1.y = pk2(o1[2], o1[3]); w1.z = pk2(o1[4], o1[5]); w1.w = pk2(o1[6], o1[7]);
            w2.x = pk2(o2[0], o2[1]); w2.y = pk2(o2[2], o2[3]); w2.z = pk2(o2[4], o2[5]); w2.w = pk2(o2[6], o2[7]);
            *(u32x4*)q[k] = w1; *(u32x4*)(q[k] + 32) = w2;
        }
    }
}

__device__ __forceinline__ void vt_phase(const Params& p, LAS unsigned char* lds) {
    const int tid_ = tid_opaque(); const int lane = tid_ & 63, wave = tid_ >> 6;
    const int gw = blockIdx.x * 8 + wave, NGW = gridDim.x * 8;
    const bf16* Pm = (const bf16*)(p.ws + WS_P); bf16* VT = (bf16*)(p.ws + WS_VT);
    LAS unsigned char* T = lds + wave * 9216;
    for (int it = gw; it < NB * 132 * 18; it += NGW) {
        const int ct = it % 18, kt = (it / 18) % 132, b = it / (18 * 132);
        const int vc0 = ct * 64; const int scol = vc0 < 512 ? C_AV + vc0 : (vc0 < 640 ? C_SV + (vc0 - 512) : C_NV + (vc0 - 640));
        const int krow0 = kt < 128 ? b * SEQ + kt * 64 : MLAT + b * CTXL + (kt - 128) * 64;
        const int rr = lane >> 3, ch = lane & 7;
#pragma unroll
        for (int i = 0; i < 8; ++i) { const int r = i * 8 + rr; *(LAS u32x4*)(T + r * 144 + ch * 16) = *(const u32x4*)(Pm + (size_t)(krow0 + r) * LDP + scol + ch * 8); }
        LDS_WAIT();
#pragma unroll
        for (int i = 0; i < 8; ++i) { const int c = i * 8 + rr;
            unsigned short v[8];
#pragma unroll
            for (int j = 0; j < 8; ++j) v[j] = *(const LAS unsigned short*)(T + (32 * (ch >> 2) + 16 * (j >> 2) + 4 * (ch & 3) + (j & 3)) * 144 + c * 2);
            u32x4 o; o.x = v[0] | ((unsigned)v[1] << 16); o.y = v[2] | ((unsigned)v[3] << 16); o.z = v[4] | ((unsigned)v[5] << 16); o.w = v[6] | ((unsigned)v[7] << 16);
            *(u32x4*)(VT + (size_t)(b * NVC + vc0 + c) * NKEY + kt * 64 + ch * 8) = o; }
        LDS_WAIT();
    }
}

#ifndef MIXREP
#define MIXREP 1
#endif
#ifndef INREP
#define INREP 1
#endif
#ifndef CVREP
#define CVREP 1
#endif
#ifndef P3REP
#define P3REP 1
#endif
#ifndef MGREP
#define MGREP 1
#endif
#ifndef FFREP
#define FFREP 1
#endif
#ifndef SYNCREP
#define SYNCREP 0
#endif
#ifndef ROWREP
#define ROWREP 1
#endif
#ifndef MISCREP
#define MISCREP 1
#endif
#ifndef SOREP
#define SOREP 1
#endif
__global__ void __launch_bounds__(NT, 2) fwd_megakernel(Params p) {
    extern __shared__ __attribute__((aligned(16))) unsigned char lds_raw[];
    LAS unsigned char* lds = (LAS unsigned char*)lds_raw;
    cg::grid_group grid = cg::this_grid();
    { const int t0_ = tid_opaque(); if (t0_ < 16) ((LAS unsigned*)(lds + LDS_BARST))[t0_] = 0u; }
    __syncthreads();
    (void)xcd_barrier_post((unsigned*)(p.ws + WS_BAR), (volatile LAS unsigned*)(lds + LDS_BARST));
#define GSYNC() do { unsigned long long bp_ = (unsigned long long)(p.ws + WS_BAR); asm volatile("" : "+s"(bp_)); XcdBarrier b2_; b2_.bar = (unsigned*)bp_; b2_.x = xb_xcc_id(); b2_.st = (volatile LAS unsigned*)(lds + LDS_BARST); xcd_barrier(b2_); } while (0)
    const int G = gridDim.x, bx = blockIdx.x;
#define ROWIDS() const int tid = tid_opaque(), lane = tid & 63, wave = __builtin_amdgcn_readfirstlane(tid >> 6); const int gw = bx * 8 + wave, NGW = G * 8; (void)lane; (void)gw; (void)NGW
    unsigned char* ws = p.ws;
    float* MOD = (float*)(ws + WS_MOD);
    bf16* ACT = (bf16*)(ws + WS_ACT); bf16* Pm = (bf16*)(ws + WS_P); bf16* FH = (bf16*)(ws + WS_FH); bf16* Y = (bf16*)(ws + WS_Y);
    bf16* YS = (bf16*)(ws + WS_YS); float* CX = (float*)(ws + WS_CX); float* SSQ = (float*)(ws + WS_SSQ);
    const unsigned char* wt = ws + WS_WT;

    for (int rep_ = 0; rep_ < MISCREP; ++rep_) for (int it = bx; it < 192; it += G) mod_item(p, it, lds);
    { const int tid = tid_opaque(); const int gt = bx * NT + tid, GT = G * NT;
    for (int idx = gt; idx < SEQ * 32; idx += GT) { const int pos = idx >> 5, f = idx & 31; const float inv = powf(10000.0f, -(float)(f & 15) / 16.0f);
        const float t = (float)(f < 16 ? (pos >> 6) : (pos & 63)); const float ang = t * inv;
        ((float*)(ws + WS_COS))[idx] = cosf(ang); ((float*)(ws + WS_SIN))[idx] = sinf(ang); }
    if (bx == 0 && tid < 2) { const int l = tid; float s1 = 0.f, s2 = 0.f;
        for (int i = 0; i < 64; ++i) { s1 += p.in[I_LQ1][l * 64 + i] * p.in[I_LK1][l * 64 + i]; s2 += p.in[I_LQ2][l * 64 + i] * p.in[I_LK2][l * 64 + i]; }
        ((float*)(ws + WS_LAM))[l] = expf(s1) - expf(s2) + (0.8f - 0.6f * expf(-0.3f * (float)l)); } }
    __syncthreads();
    for (int rep_ = 0; rep_ < CVREP; ++rep_) convert_weights(p, 0, lds);
    grid.sync();
    for (int rep_ = 0; rep_ < ROWREP; ++rep_) { ROWIDS();
    for (int r = gw; r < MALL; r += NGW) {
        const bool lat = r < MLAT; const int v = lat ? (r >> 13) : 2;
        const float* xr = lat ? p.in[I_X] + (size_t)r * D : p.in[I_CTX] + (size_t)(r - MLAT) * D;
        row_pass<false, true>(xr, nullptr, nullptr, nullptr, nullptr, nullptr, p.in[I_GPREMIX], MOD + (size_t)(v) * 12288, MOD + (size_t)(v) * 12288 + D, ACT + (size_t)r * D, lane);
        if (lane == 0) SSQ[r] = 0.f;
    } }
    GSYNC();

#pragma unroll 1
    for (int layer = 0; layer < NLAYER; ++layer) {
        const bool need_ctx = layer + 1 < NLAYER;
        const int MR = need_ctx ? MALL : MLAT;
        const float* MODL = MOD + (size_t)layer * 3 * 12288;
        { pg8::Gemm g{ACT, (const bf16*)(wt + WT_IN), MALL, LDP, D}; pg8::StaticOrder S; S.init(MALL, LDP, G, bx);
          pg8::EpiBf<0> E{Pm, LDP}; for (int rep_ = 0; rep_ < INREP; ++rep_) pg8::gemm_phase<pg8::EpiBf<0>, pg8::StaticOrder, true, true>(lds, g, S, E); }
        GSYNC();
        for (int rep_ = 0; rep_ < P3REP; ++rep_) {
        for (int u = bx; u < NB * NCH * 2; u += G) { const int g2 = u & 1, cc = (u >> 1) % NCH, b = (u >> 1) / NCH; ssd_state_unit(p, layer, lds, b, cc, g2); }
        __syncthreads();
        vt_phase(p, lds); __syncthreads(); }
        rope_phase(p);
        GSYNC();
        for (int rep_ = 0; rep_ < MISCREP; ++rep_) ssd_scan_phase(p);
        GSYNC();
        for (int rep_ = 0; rep_ < SYNCREP; ++rep_) GSYNC();
        {
            const int n_diff = 512, n_swa = 512, n_na = 1024, n_ssd = NB * (need_ctx ? NCH : 64) * 2;
            const int n_cd = need_ctx ? 16 : 0, n_cs = need_ctx ? 16 : 0, n_cn = need_ctx ? 32 : 0;
            const int total = n_diff + n_swa + n_na + n_ssd + n_cd + n_cs + n_cn;
            for (int u0 = bx; u0 < n_diff; u0 += G) attn_unit<0>(p, layer, lds, (u0 & 7) >> 2, u0 & 3, u0 >> 3, false);
            unsigned* qc = (unsigned*)(ws + WS_BAR + 14336) + layer * 64;
            volatile LAS unsigned* qslot = (volatile LAS unsigned*)(lds + LDS_BARST + 16);
            for (;;) {
                __syncthreads();
                if (tid_opaque() == 0) *qslot = __hip_atomic_fetch_add(qc, 1u, __ATOMIC_RELAXED, __HIP_MEMORY_SCOPE_AGENT);
                __syncthreads();
                int u = (int)*qslot;
                if (u >= total - n_diff) break;
                if (u < n_ssd) { const int g2 = u & 1; int cc = (u >> 1) % (need_ctx ? NCH : 64); const int b = (u >> 1) / (need_ctx ? NCH : 64); if (!need_ctx) cc += 2; ssd_out_unit(p, layer, lds, b, cc, g2); continue; } u -= n_ssd;
                if (u < n_swa) { attn_unit<1>(p, layer, lds, (u & 3) >> 1, u & 1, u >> 2, false); continue; } u -= n_swa;
                if (u < n_na) { attn_unit<2>(p, layer, lds, (u & 7) >> 2, u & 3, u >> 3, false); continue; } u -= n_na;
                if (u < n_cd) { attn_unit<0>(p, layer, lds, (u & 7) >> 2, u & 3, u >> 3, true); continue; } u -= n_cd;
                if (u < n_cs) { attn_unit<1>(p, layer, lds, (u & 3) >> 1, u & 1, u >> 2, true); continue; } u -= n_cs;
                attn_unit<2>(p, layer, lds, (u & 7) >> 2, u & 3, u >> 3, true);
            }
        }
        GSYNC();
        for (int rep_ = 0; rep_ < MGREP; ++rep_) { pg8::MergeOrder S; S.init(MR, D, G, bx);
          pg8::Gemm g{YS, (const bf16*)(wt + WT_BR), MR, D, 512, (size_t)MALL * 512 * 2, (size_t)D * 512 * 2};
          pg8::EpiMerge E{Pm, LDP, C_GATE, ACT, D, SSQ}; pg8::gemm_phase<pg8::EpiMerge, pg8::MergeOrder, true, true>(lds, g, S, E); }
        GSYNC();
        { pg8::Gemm g{ACT, (const bf16*)(wt + WT_OUT), MR, D, D}; pg8::StaticOrder S; S.init(MR, D, G, bx);
          pg8::EpiBf<0> E{Y, D}; for (int rep_ = 0; rep_ < FFREP; ++rep_) pg8::gemm_phase<pg8::EpiBf<0>, pg8::StaticOrder, true, true>(lds, g, S, E); }
        GSYNC();
        for (int rep_ = 0; rep_ < (layer == 0 ? ROWREP : 1); ++rep_) { ROWIDS();
        for (int r = gw; r < MR; r += NGW) {
            const bool lat = r < MLAT; const int v = lat ? (r >> 13) : 2;
            const float* xr = lat ? (layer == 0 ? p.in[I_X] + (size_t)r * D : p.out + (size_t)r * D) : (layer == 0 ? p.in[I_CTX] + (size_t)(r - MLAT) * D : CX + (size_t)(r - MLAT) * D);
            float* xo = lat ? p.out + (size_t)r * D : CX + (size_t)(r - MLAT) * D;
            const float* mv = MODL + (size_t)v * 12288;
            if (!lat) { float* yc = (float*)(ws + WS_YC) + (size_t)(r - MLAT) * D;
#pragma unroll
                for (int j = 0; j < 8; ++j) *(f32x4*)(yc + (j * 64 + lane) * 4) = (f32x4){0.f, 0.f, 0.f, 0.f}; }
            row_pass<true, true>(xr, Y + (size_t)r * D, nullptr, p.in[I_GPOSTMIX] + layer * D, mv + 2 * D, xo, p.in[I_GPREMLP] + layer * D, mv + 3 * D, mv + 4 * D, ACT + (size_t)r * D, lane);
        } }
        GSYNC();
        { pg8::Gemm g{ACT, (const bf16*)(wt + WT_F1), MR, DFF, D}; pg8::StaticOrder S; S.init(MR, DFF, G, bx);
          pg8::EpiBf<2> E{FH, DFF}; for (int rep_ = 0; rep_ < FFREP; ++rep_) pg8::gemm_phase<pg8::EpiBf<2>, pg8::StaticOrder, true, true>(lds, g, S, E); }
        GSYNC();
        { pg8::Gemm g{FH, (const bf16*)(wt + WT_F2), MLAT, D, DFF}; pg8::StaticOrder S; S.init(MLAT, D, G, bx);
          pg8::EpiBf<0> E{Y, D}; for (int rep_ = 0; rep_ < FFREP; ++rep_) pg8::gemm_phase<pg8::EpiBf<0>, pg8::StaticOrder, true, true>(lds, g, S, E); }
        if (need_ctx) { pg8::Gemm g{FH + (size_t)MLAT * DFF, (const bf16*)(wt + WT_F2), MCTX, D, 2048, (size_t)2048 * 2, (size_t)2048 * 2, DFF}; pg8::SplitOrder S; S.init(MCTX, D, G, bx);
          pg8::EpiAtomicF32 E{(float*)(ws + WS_YC), D}; pg8::gemm_phase<pg8::EpiAtomicF32, pg8::SplitOrder, true, true>(lds, g, S, E); }
        GSYNC();
        if (need_ctx) {
            const float* MODN = MOD + (size_t)(layer + 1) * 3 * 12288;
            { ROWIDS();
            for (int r = gw; r < MALL; r += NGW) {
                const bool lat = r < MLAT; const int v = lat ? (r >> 13) : 2;
                float* xo = lat ? p.out + (size_t)r * D : CX + (size_t)(r - MLAT) * D;
                row_pass<true, true>(xo, Y + (size_t)r * D, lat ? nullptr : (const float*)(ws + WS_YC) + (size_t)(r - MLAT) * D, p.in[I_GPOSTMLP] + layer * D, MODL + (size_t)v * 12288 + 5 * D, xo,
                                     p.in[I_GPREMIX] + (layer + 1) * D, MODN + (size_t)v * 12288, MODN + (size_t)v * 12288 + D, ACT + (size_t)r * D, lane);
                if (lane == 0) SSQ[r] = 0.f;
            } }
            __syncthreads();
            for (int rep_ = 0; rep_ < CVREP; ++rep_) convert_weights(p, layer + 1, lds);
            GSYNC();
        } else {
            ROWIDS();
            for (int r = gw; r < MLAT; r += NGW) {
                float* xo = p.out + (size_t)r * D;
                row_pass<true, false>(xo, Y + (size_t)r * D, nullptr, p.in[I_GPOSTMLP] + layer * D, MODL + (size_t)(r >> 13) * 12288 + 5 * D, xo, nullptr, nullptr, nullptr, nullptr, lane);
            }
        }
    }
}

extern "C" void kernel_launch(void* const* d_in, const int* in_sizes, int n_in, void* d_out, int out_size, void* d_ws, size_t ws_size, hipStream_t stream) {
    static int grid = 0;
    if (grid == 0) {
        if (n_in != 28 || out_size != MLAT * D || ws_size < WS_END) { fprintf(stderr, "kernel_launch: unexpected problem (n_in %d out %d ws %zu)\n", n_in, out_size, ws_size); grid = -1; return; }
        int dev = 0, cus = 0, per_cu = 0;
        (void)hipGetDevice(&dev); (void)hipDeviceGetAttribute(&cus, hipDeviceAttributeMultiprocessorCount, dev);
        (void)hipFuncSetAttribute((const void*)fwd_megakernel, hipFuncAttributeMaxDynamicSharedMemorySize, LDS_BYTES);
        (void)hipOccupancyMaxActiveBlocksPerMultiprocessor(&per_cu, (const void*)fwd_megakernel, NT, LDS_BYTES);
        (void)hipGetLastError();
        if (per_cu < 1) per_cu = 1;
        grid = cus * per_cu;
        fprintf(stderr, "kernel_launch: cus %d per_cu %d grid %d ws %zu\n", cus, per_cu, grid, ws_size);
    }
    if (grid < 0) return;
    (void)hipMemsetAsync((unsigned char*)d_ws + WS_BAR, 0, 16384, stream);
    Params p{};
    for (int i = 0; i < 28; ++i) p.in[i] = (const float*)d_in[i];
    p.out = (float*)d_out; p.ws = (unsigned char*)d_ws;
    void* args[] = {&p};
    hipError_t e = hipLaunchCooperativeKernel((const void*)fwd_megakernel, dim3(grid), dim3(NT), args, LDS_BYTES, stream);
    if (e != hipSuccess) fprintf(stderr, "cooperative launch failed: %s (grid %d)\n", hipGetErrorString(e), grid);
}
```
